# Optimizing an MI355X kernel written in HIP

```python
import jax
import jax.numpy as jnp
from jax import lax
import numpy as np

D_MODEL = 1024
BATCH = 32
SEQ = 2048
DEPTH = 2

N_MIXERS = 2
MIX_WIDTH = D_MODEL
X_WIDTH = D_MODEL // 4
N_X_HEADS = 4
X_HEAD_DIM = X_WIDTH // N_X_HEADS
SEQ_MIX_WIDTH = MIX_WIDTH - X_WIDTH
LIN_HEAD_DIM = 128
N_LIN_HEADS = SEQ_MIX_WIDTH // LIN_HEAD_DIM
CONV_WIDTH = 4
CHUNK = 64
SB_HEAD_DIM = 64
N_SB_HEADS = SEQ_MIX_WIDTH // SB_HEAD_DIM
SB_BLOCK = 128
N_MEM = 256
D_FF = 4 * D_MODEL
EPS = 1e-6
N_A_LAYERS = (DEPTH + 1) // 2
N_B_LAYERS = DEPTH // 2
IN_A = 4 * SEQ_MIX_WIDTH + 2 * N_LIN_HEADS + X_WIDTH
IN_B = 3 * SEQ_MIX_WIDTH + X_WIDTH

kernel_name = 'hybrid_gdn_stickbreak_memory_trunk'


def rms_norm(x, g):
    xf = x.astype(jnp.float32)
    y = xf * lax.rsqrt(jnp.mean(xf * xf, axis=-1, keepdims=True) + EPS)
    return (y * g.astype(jnp.float32)).astype(x.dtype)


def l2norm(x):
    return x * lax.rsqrt(jnp.sum(x * x, axis=-1, keepdims=True) + EPS)


def causal_conv(x, w):
    c = x.shape[-1]
    return lax.conv_general_dilated(
        x, w[:, None, :].astype(x.dtype), window_strides=(1,),
        padding=[(CONV_WIDTH - 1, 0)], dimension_numbers=('NWC', 'WIO', 'NWC'),
        feature_group_count=c)


def gated_deltanet(p, conv_w, a_log, dt_bias, o_gain):
    B, S, _ = p.shape
    H, Dh, C, W = N_LIN_HEADS, LIN_HEAD_DIM, CHUNK, SEQ_MIX_WIDTH
    nc = S // C
    qkv = jax.nn.silu(causal_conv(p[..., :3 * W], conv_w)).astype(jnp.float32)
    gate = p[..., 3 * W:4 * W].astype(jnp.float32)
    beta = jax.nn.sigmoid(p[..., 4 * W:4 * W + H].astype(jnp.float32))
    g = -jnp.exp(a_log.astype(jnp.float32)) * jax.nn.softplus(
        p[..., 4 * W + H:].astype(jnp.float32) + dt_bias.astype(jnp.float32))
    q = l2norm(qkv[..., :W].reshape(B, S, H, Dh)) * (Dh ** -0.5)
    k = l2norm(qkv[..., W:2 * W].reshape(B, S, H, Dh))
    v = qkv[..., 2 * W:].reshape(B, S, H, Dh)

    def chunked(t):
        t = t.reshape((B, nc, C) + t.shape[2:])
        return jnp.moveaxis(jnp.moveaxis(t, 1, 0), 3, 2)

    q, k, v, beta = chunked(q), chunked(k), chunked(v), chunked(beta)
    gc = jnp.cumsum(chunked(g), axis=-1)
    idx = jnp.arange(C)
    causal = idx[:, None] >= idx[None, :]
    strict = idx[:, None] > idx[None, :]
    decay = jnp.exp(jnp.where(causal, gc[..., :, None] - gc[..., None, :], -jnp.inf))
    kb = k * beta[..., None]
    lower = jnp.where(strict, jnp.einsum('nbhcd,nbhsd->nbhcs', kb, k) * decay, 0.0)
    eye = jnp.eye(C, dtype=jnp.float32)
    rhs = jnp.concatenate([v * beta[..., None], kb * jnp.exp(gc)[..., None]], axis=-1)
    sol = lax.linalg.triangular_solve(eye + lower, rhs, left_side=True, lower=True,
                                      unit_diagonal=True)
    u, w = sol[..., :Dh], sol[..., Dh:]
    intra = jnp.einsum('nbhcd,nbhsd->nbhcs', q, k) * decay
    q_dec = q * jnp.exp(gc)[..., None]
    k_dec = k * jnp.exp(gc[..., -1:] - gc)[..., None]
    chunk_decay = jnp.exp(gc[..., -1])

    def step(state, inp):
        u_c, w_c, q_c, k_c, a_c, d_c = inp
        v_new = u_c - jnp.einsum('bhcd,bhde->bhce', w_c, state)
        o_c = jnp.einsum('bhcd,bhde->bhce', q_c, state) + jnp.einsum('bhcs,bhse->bhce', a_c, v_new)
        state = state * d_c[..., None, None] + jnp.einsum('bhcd,bhce->bhde', k_c, v_new)
        return state, o_c

    state0 = jnp.zeros((B, H, Dh, Dh), jnp.float32)
    _, o = lax.scan(step, state0, (u, w, q_dec, k_dec, intra, chunk_decay))
    o = jnp.swapaxes(jnp.moveaxis(o, 0, 1), 2, 3).reshape(B, S, H, Dh)
    o = o * lax.rsqrt(jnp.mean(o * o, axis=-1, keepdims=True) + EPS) * o_gain.astype(jnp.float32)
    o = o * jax.nn.silu(gate.reshape(B, S, H, Dh))
    return o.reshape(B, S, W)


def stick_breaking_attention(q, k, v):
    B, S, H, Dh = q.shape
    scale = Dh ** -0.5
    outs = []
    for blk in range(S // SB_BLOCK):
        t0 = blk * SB_BLOCK
        t1 = t0 + SB_BLOCK
        kb, vb = k[:, :t1], v[:, :t1]
        z = jnp.einsum('bthd,bshd->bhts', q[:, t0:t1], kb,
                       preferred_element_type=jnp.float32) * scale
        t_idx = t0 + jnp.arange(SB_BLOCK)[:, None]
        s_idx = jnp.arange(t1)[None, :]
        before = s_idx < t_idx
        log_beta = jax.nn.log_sigmoid(z)
        log_1m_beta = jnp.where(before, jax.nn.log_sigmoid(-z), 0.0)
        tail = lax.cumsum(log_1m_beta, axis=3, reverse=True) - log_1m_beta
        a = jnp.where(before, jnp.exp(log_beta + tail), 0.0)
        outs.append(jnp.einsum('bhts,bshd->bthd', a.astype(vb.dtype), vb))
    return jnp.concatenate(outs, axis=1).reshape(B, S, H * Dh)


def memory_attention(q, mem_kv):
    B, S, _ = q.shape
    q = q.reshape(B, S, N_X_HEADS, X_HEAD_DIM)
    k = mem_kv[..., :X_WIDTH].reshape(B, N_MEM, N_X_HEADS, X_HEAD_DIM)
    v = mem_kv[..., X_WIDTH:].reshape(B, N_MEM, N_X_HEADS, X_HEAD_DIM)
    s = jnp.einsum('bshd,bmhd->bhsm', q, k, preferred_element_type=jnp.float32) * (X_HEAD_DIM ** -0.5)
    p = jax.nn.softmax(s, axis=-1).astype(v.dtype)
    return jnp.einsum('bhsm,bmhd->bshd', p, v).reshape(B, S, X_WIDTH)


def setup_inputs(seed: int = 0) -> dict:
    key = jax.random.key(seed)
    ks = jax.random.split(key, 18)
    f32 = jnp.float32
    nrm = lambda k, shape, scale: jax.random.normal(k, shape, f32) * scale
    gain = lambda k, shape: 1.0 + 0.1 * jax.random.normal(k, shape, f32)
    return {
        'x': nrm(ks[0], (BATCH, SEQ, D_MODEL), 1.0),
        'mem': nrm(ks[1], (BATCH, N_MEM, D_MODEL), 1.0),
        'mem_norm': gain(ks[2], (D_MODEL,)),
        'norm_pre_mix': gain(ks[3], (DEPTH, D_MODEL)),
        'norm_post_mix': gain(ks[4], (DEPTH, D_MODEL)),
        'norm_pre_mlp': gain(ks[5], (DEPTH, D_MODEL)),
        'norm_post_mlp': gain(ks[6], (DEPTH, D_MODEL)),
        'w_in_a': nrm(ks[7], (N_A_LAYERS, D_MODEL, IN_A), D_MODEL ** -0.5),
        'conv_w_a': nrm(ks[8], (N_A_LAYERS, CONV_WIDTH, 3 * SEQ_MIX_WIDTH), CONV_WIDTH ** -0.5),
        'a_log_a': jnp.log(jax.random.uniform(ks[9], (N_A_LAYERS, N_LIN_HEADS), f32, 0.01, 1.0)),
        'dt_bias_a': nrm(ks[10], (N_A_LAYERS, N_LIN_HEADS), 0.1),
        'onorm_a': gain(ks[11], (N_A_LAYERS, LIN_HEAD_DIM)),
        'w_in_b': nrm(ks[12], (N_B_LAYERS, D_MODEL, IN_B), D_MODEL ** -0.5),
        'w_mem_kv': nrm(ks[13], (DEPTH, D_MODEL, 2 * X_WIDTH), D_MODEL ** -0.5),
        'w_out': nrm(ks[14], (DEPTH, MIX_WIDTH, D_MODEL), MIX_WIDTH ** -0.5),
        'w_up': nrm(ks[15], (DEPTH, D_MODEL, D_FF), D_MODEL ** -0.5),
        'w_down': nrm(ks[16], (DEPTH, D_FF, D_MODEL), D_FF ** -0.5),
    }


def reference(x, mem, mem_norm, norm_pre_mix, norm_post_mix, norm_pre_mlp, norm_post_mlp,
              w_in_a, conv_w_a, a_log_a, dt_bias_a, onorm_a, w_in_b, w_mem_kv, w_out,
              w_up, w_down):
    B, S, _ = x.shape
    mem_n = rms_norm(mem, mem_norm)
    for i in range(DEPTH):
        j = i // N_MIXERS
        h = rms_norm(x, norm_pre_mix[i])
        if i % N_MIXERS == 0:
            proj = h @ w_in_a[j]
            mix = gated_deltanet(proj[..., :IN_A - X_WIDTH], conv_w_a[j], a_log_a[j],
                                 dt_bias_a[j], onorm_a[j])
            mem_q = proj[..., IN_A - X_WIDTH:]
        else:
            proj = h @ w_in_b[j]
            W = SEQ_MIX_WIDTH
            q = proj[..., :W].reshape(B, S, N_SB_HEADS, SB_HEAD_DIM)
            k = proj[..., W:2 * W].reshape(B, S, N_SB_HEADS, SB_HEAD_DIM)
            v = proj[..., 2 * W:3 * W].reshape(B, S, N_SB_HEADS, SB_HEAD_DIM)
            mix = stick_breaking_attention(q, k, v)
            mem_q = proj[..., 3 * W:]
        cross = memory_attention(mem_q, mem_n @ w_mem_kv[i])
        y = jnp.concatenate([mix.astype(x.dtype), cross.astype(x.dtype)], axis=-1) @ w_out[i]
        x = x + rms_norm(y, norm_post_mix[i])
        h = rms_norm(x, norm_pre_mlp[i])
        y = jnp.square(jax.nn.relu(h @ w_up[i])) @ w_down[i]
        x = x + rms_norm(y, norm_post_mlp[i])
    return x
```

```cpp
#include <hip/hip_runtime.h>
#include <hip/hip_cooperative_groups.h>
#include <cstdio>
#include <cstdint>
namespace cg = cooperative_groups;

#define DI __device__ __forceinline__
#define LAS __attribute__((address_space(3)))
typedef unsigned short bf16_t;
typedef short bf16x8 __attribute__((ext_vector_type(8)));
typedef short s16x4 __attribute__((ext_vector_type(4)));
typedef float f32x2 __attribute__((ext_vector_type(2)));
typedef float f32x4 __attribute__((ext_vector_type(4)));
typedef float f32x16 __attribute__((ext_vector_type(16)));
typedef unsigned u32x2 __attribute__((ext_vector_type(2)));
typedef unsigned u32x4 __attribute__((ext_vector_type(4)));
typedef __bf16 bf16x2_t __attribute__((ext_vector_type(2)));

constexpr int DM = 1024, BATCH = 32, SEQ = 2048, NTOK = BATCH * SEQ;
constexpr int NMEM = 256, NMEMTOK = BATCH * NMEM;
constexpr int LDA_P = 3584;
constexpr int LDB_P = 2560;
constexpr int INA_SRC = 3340;
constexpr int DFF = 4096;
constexpr int NCH = 32;
constexpr int NCHH = BATCH * NCH * 6;
constexpr float EPSF = 1e-6f;

constexpr size_t MiB = 1u << 20;
constexpr size_t WS_WINA = 0;
constexpr size_t WS_WINB = 8 * MiB;
constexpr size_t WS_WMKV = 14 * MiB;
constexpr size_t WS_WOUT = 16 * MiB;
constexpr size_t WS_WUP = 20 * MiB;
constexpr size_t WS_WDN = 36 * MiB;
constexpr size_t WS_MEMN = 52 * MiB;
constexpr size_t WS_MEMKV = 68 * MiB;
constexpr size_t WS_XN = 84 * MiB;
constexpr size_t WS_BIG = 212 * MiB;
constexpr size_t WS_QD = 724 * MiB;
constexpr size_t WS_KD = 820 * MiB;
constexpr size_t WS_XRES = WS_QD;
constexpr size_t WS_T = 916 * MiB;
constexpr size_t WS_GC = 1012 * MiB;
constexpr size_t WS_RSTAT = WS_GC;
constexpr size_t WS_BAR = 1014 * MiB;
constexpr size_t WS_END = 1015 * MiB;
constexpr size_t DO_U = 0, DO_W = 96 * MiB, DO_AI = 192 * MiB;

constexpr int LDS_BAR_OFF = 159744;
constexpr int LDS_BYTES = 160000;

DI float bf2f(unsigned short h) { return __uint_as_float(((unsigned)h) << 16); }
DI unsigned pk2(float lo, float hi) { f32x2 v = {lo, hi}; bf16x2_t b = __builtin_convertvector(v, bf16x2_t); return __builtin_bit_cast(unsigned, b); }
DI float wave_sum(float v) {
#pragma unroll
    for (int o = 1; o < 64; o <<= 1) v += __shfl_xor(v, o);
    return v;
}
DI void unpack8(u32x4 v, float* f) {
    f[0] = __uint_as_float(v.x << 16); f[1] = __uint_as_float(v.x & 0xffff0000u);
    f[2] = __uint_as_float(v.y << 16); f[3] = __uint_as_float(v.y & 0xffff0000u);
    f[4] = __uint_as_float(v.z << 16); f[5] = __uint_as_float(v.z & 0xffff0000u);
    f[6] = __uint_as_float(v.w << 16); f[7] = __uint_as_float(v.w & 0xffff0000u);
}
DI u32x4 pack8(const float* f) { u32x4 o; o.x = pk2(f[0], f[1]); o.y = pk2(f[2], f[3]); o.z = pk2(f[4], f[5]); o.w = pk2(f[6], f[7]); return o; }
DI s16x4 tr_read(const LAS unsigned char* p) {
    typedef short v4i16_t __attribute__((ext_vector_type(4)));
    return __builtin_bit_cast(s16x4, __builtin_amdgcn_ds_read_tr16_b64_v4i16((LAS v4i16_t*)p));
}
DI bf16x8 cat4(s16x4 lo, s16x4 hi) { return (bf16x8){lo[0], lo[1], lo[2], lo[3], hi[0], hi[1], hi[2], hi[3]}; }
#define MFMA32(a, b, c) __builtin_amdgcn_mfma_f32_32x32x16_bf16((a), (b), (c), 0, 0, 0)
#define MFMA16(a, b, c) __builtin_amdgcn_mfma_f32_16x16x32_bf16((a), (b), (c), 0, 0, 0)
DI float fast_exp(float x) { return __builtin_amdgcn_exp2f(x * 1.4426950408889634f); }
DI float fast_rcp(float x) { return __builtin_amdgcn_rcpf(x); }

DI float row16_sum(float v) {
    v += __builtin_bit_cast(float, __builtin_amdgcn_update_dpp(0, __builtin_bit_cast(int, v), 0x128, 0xF, 0xF, false));
    v += __builtin_bit_cast(float, __builtin_amdgcn_update_dpp(0, __builtin_bit_cast(int, v), 0x124, 0xF, 0xF, false));
    v += __builtin_bit_cast(float, __builtin_amdgcn_update_dpp(0, __builtin_bit_cast(int, v), 0x122, 0xF, 0xF, false));
    v += __builtin_bit_cast(float, __builtin_amdgcn_update_dpp(0, __builtin_bit_cast(int, v), 0x121, 0xF, 0xF, false));
    return v;
}
struct Params {
    const float *x, *mem, *mem_norm, *n_pre_mix, *n_post_mix, *n_pre_mlp, *n_post_mlp, *w_in_a, *conv_w, *a_log, *dt_bias, *onorm, *w_in_b, *w_mem_kv, *w_out, *w_up, *w_down;
    float* out; unsigned char* ws; int ph_lo, ph_hi;
};

namespace pg8 {
constexpr int BM = 256, BK = 64, HALF = 128, HTB = HALF * BK * 2, STAGE_BYTES = 8 * HTB, NXCD = 8, WGM = 8;
DI int lds_byte(int r, int c) { const int st = (r >> 4) * 2 + (c >> 5), rr = r & 15, cc = c & 31, ob = rr * 64 + cc * 2; return st * 1024 + (ob ^ (((ob >> 9) & 1) << 5)); }
DI void stage_rc(int b, int& R, int& C) { const int st = b / 1024, sb = b % 1024, swz = sb ^ (((sb >> 9) & 1) << 5); R = (st >> 1) * 16 + swz / 64; C = (st & 1) * 32 + (swz % 64) / 2; }
DI int perm32(int rho) { const int n = rho >> 4, i = rho & 15; return 8 * (i >> 2) + 4 * n + (i & 3); }
struct Unit { int pm, pn; };
struct Gemm { const bf16_t* A; const bf16_t* Bt; int M, N, K; };
struct StaticOrder {
    int nM, nN, nwg, G, c;
    DI void init(int M, int N, int G_, int c_) { nM = M / BM; nN = N / BM; nwg = nM * nN; G = G_; c = c_; }
    DI bool next(int i, Unit& u) const {
        const long L = (long)i * G + c; if (L >= nwg) return false;
        int wgid = (int)L; { const int q = nwg / NXCD, r = nwg % NXCD, xcd = wgid % NXCD, off = wgid / NXCD; wgid = (xcd < r ? xcd * (q + 1) : r * (q + 1) + (xcd - r) * q) + off; }
        const int nig = WGM * nN, gid = wgid / nig, fm = gid * WGM, gsz = (nM - fm) < WGM ? (nM - fm) : WGM;
        u.pm = fm + ((wgid % nig) % gsz); u.pn = (wgid % nig) / gsz; return true;
    }
};
template <int ACT> struct EpiBf16 {
    static constexpr bool PERM = true;
    bf16_t* O; int ldc; const float* rs;
    DI void operator()(const f32x4 (&acc)[2][2][4][2], const Unit& u, int wr, int wc, int fr, int fq) const {
        const int row0 = u.pm * BM + wr * 64 + fr; const int col0 = u.pn * BM + wc * 32 + 8 * fq;
#pragma unroll
        for (int ai = 0; ai < 2; ++ai)
#pragma unroll
            for (int m = 0; m < 4; ++m) { bf16_t* rowp = O + (size_t)(row0 + ai * HALF + m * 16) * ldc + col0;
                float sc = 1.f; if (rs) { sc = rs[row0 + ai * HALF + m * 16]; if (ACT == 2) sc = sc * sc; }
#pragma unroll
                for (int bj = 0; bj < 2; ++bj) { f32x4 v0 = acc[ai][bj][m][0], v1 = acc[ai][bj][m][1];
                    if (ACT == 2) {
#pragma unroll
                        for (int e = 0; e < 4; ++e) { float a = fmaxf(v0[e], 0.f), b = fmaxf(v1[e], 0.f); v0[e] = a * a; v1[e] = b * b; } }
                    v0 = v0 * sc; v1 = v1 * sc;
                    u32x4 w; w.x = pk2(v0[0], v0[1]); w.y = pk2(v0[2], v0[3]); w.z = pk2(v1[0], v1[1]); w.w = pk2(v1[2], v1[3]);
                    *(u32x4*)(rowp + bj * HALF) = w; } }
    }
};

template <class Epi>
DI void gemm_phase(LAS unsigned char* lds, const Gemm g, const StaticOrder& S, const Epi& E) {
    int tid = threadIdx.x; asm volatile("" : "+v"(tid));
    const int wid = __builtin_amdgcn_readfirstlane(tid >> 6), lane = tid & 63, wr = wid >> 2, wc = wid & 3, fr = lane & 15, fq = lane >> 4;
    const int K = g.K, nt = K / BK;
    unsigned voffA[2], voffB[2];
#pragma unroll
    for (int i = 0; i < 2; ++i) { int R, C; stage_rc(tid * 16 + i * 8192, R, C); const int Rb = Epi::PERM ? ((R & ~31) + perm32(R & 31)) : R;
        voffA[i] = (unsigned)(R * K + C) * 2u; voffB[i] = (unsigned)(Rb * K + C) * 2u; }
    const size_t kstep = (size_t)(BK * 2);
    const size_t hstep = (size_t)HALF * K * 2;
    const size_t tstep = 2 * hstep;
    const unsigned ldsw = (unsigned)wid * 1024u;
    const int aoff = lds_byte(wr * 64 + fr, fq * 8), boff = lds_byte(wc * 32 + fr, fq * 8);
#define PG8_SA(b, h) (((b) * 2 + (h)) * HTB)
#define PG8_SB(b, h) ((4 + (b) * 2 + (h)) * HTB)
#define PG8_STAGE(bufoff, gbase, voff) do { _Pragma("unroll") for (int _i = 0; _i < 2; ++_i) \
        __builtin_amdgcn_global_load_lds((const unsigned*)((const char*)(gbase) + (voff)[_i]), (LAS unsigned*)(lds + (bufoff) + ldsw + _i * 8192), 16, 0, 0); } while (0)
#define PG8_LDA(dst, b, h) do { _Pragma("unroll") for (int m = 0; m < 4; ++m) _Pragma("unroll") for (int k = 0; k < 2; ++k) dst[m][k] = *(const LAS bf16x8*)(lds + PG8_SA(b, h) + aoff + m * 2048 + k * 1024); } while (0)
#define PG8_LDB(dst, b, h) do { _Pragma("unroll") for (int n = 0; n < 2; ++n) _Pragma("unroll") for (int k = 0; k < 2; ++k) dst[n][k] = *(const LAS bf16x8*)(lds + PG8_SB(b, h) + boff + n * 2048 + k * 1024); } while (0)
#define PG8_MMA(ai, bj, At, Bt) do { __builtin_amdgcn_s_setprio(1); _Pragma("unroll") for (int m = 0; m < 4; ++m) _Pragma("unroll") for (int n = 0; n < 2; ++n) _Pragma("unroll") for (int k = 0; k < 2; ++k) \
        acc[ai][bj][m][n] = __builtin_amdgcn_mfma_f32_16x16x32_bf16(Bt[n][k], At[m][k], acc[ai][bj][m][n], 0, 0, 0); __builtin_amdgcn_s_setprio(0); } while (0)
#define PG8_WAIT_V(n) asm volatile("s_waitcnt vmcnt(" #n ")" ::: "memory")
#define PG8_WAIT_L(n) asm volatile("s_waitcnt lgkmcnt(" #n ")" ::: "memory")
#define PG8_BAR __builtin_amdgcn_s_barrier()
#define PG8_SCHED __builtin_amdgcn_sched_barrier(0)
    Unit cur, nxt; int ui = 0;
    if (!S.next(0, cur)) return;
    f32x4 acc[2][2][4][2];
#pragma unroll
    for (int a = 0; a < 2; ++a)
#pragma unroll
        for (int b = 0; b < 2; ++b)
#pragma unroll
            for (int m = 0; m < 4; ++m)
#pragma unroll
                for (int n = 0; n < 2; ++n) acc[a][b][m][n] = (f32x4){0.f, 0.f, 0.f, 0.f};
    bf16x8 At[4][2], B0[2][2], B1[2][2];
    const char* cA = (const char*)g.A + (size_t)cur.pm * tstep; const char* cB = (const char*)g.Bt + (size_t)cur.pn * tstep;
    PG8_STAGE(PG8_SB(0, 0), cB, voffB); PG8_STAGE(PG8_SB(0, 1), cB + hstep, voffB); PG8_STAGE(PG8_SA(0, 0), cA, voffA); PG8_STAGE(PG8_SA(0, 1), cA + hstep, voffA);
    if (wr == 1) PG8_BAR;
    PG8_WAIT_V(2); PG8_BAR;
    PG8_STAGE(PG8_SB(1, 0), cB + kstep, voffB); PG8_STAGE(PG8_SA(1, 0), cA + kstep, voffA); PG8_STAGE(PG8_SB(1, 1), cB + hstep + kstep, voffB);
    PG8_WAIT_V(6); PG8_BAR;
    for (;;) {
        const bool has_next = S.next(ui + 1, nxt);
        const char* nA = has_next ? (const char*)g.A + (size_t)nxt.pm * tstep : cA; const char* nB = has_next ? (const char*)g.Bt + (size_t)nxt.pn * tstep : cB;
        for (int t = 0; t < nt; t += 2) {
            const bool last = (t == nt - 2);
            const char* a1 = cA + (size_t)(t + 1) * kstep;
            const char* a2 = last ? nA : cA + (size_t)(t + 2) * kstep; const char* b2 = last ? nB : cB + (size_t)(t + 2) * kstep;
            const char* a3 = a2 + kstep; const char* b3 = b2 + kstep;
            PG8_LDB(B0, 0, 0); PG8_LDB(B1, 0, 1); PG8_SCHED; PG8_LDA(At, 0, 0); PG8_STAGE(PG8_SA(1, 1), a1 + hstep, voffA);
            PG8_WAIT_V(8); PG8_WAIT_L(0); PG8_BAR; PG8_MMA(0, 0, At, B0); PG8_MMA(0, 1, At, B1); PG8_BAR; PG8_SCHED;
            PG8_LDA(At, 0, 1); PG8_STAGE(PG8_SB(0, 0), b2, voffB); PG8_STAGE(PG8_SB(0, 1), b2 + hstep, voffB); PG8_STAGE(PG8_SA(0, 0), a2, voffA);
            PG8_WAIT_V(8); PG8_WAIT_L(0); PG8_BAR; PG8_MMA(1, 0, At, B0); PG8_MMA(1, 1, At, B1); PG8_BAR; PG8_SCHED;
            PG8_LDB(B0, 1, 0); PG8_LDB(B1, 1, 1); PG8_SCHED; PG8_LDA(At, 1, 0); PG8_STAGE(PG8_SA(0, 1), a2 + hstep, voffA);
            PG8_WAIT_V(8); PG8_WAIT_L(0); PG8_BAR; PG8_MMA(0, 0, At, B0); PG8_MMA(0, 1, At, B1); PG8_BAR; PG8_SCHED;
            PG8_LDA(At, 1, 1); PG8_STAGE(PG8_SB(1, 0), b3, voffB); PG8_STAGE(PG8_SB(1, 1), b3 + hstep, voffB); PG8_STAGE(PG8_SA(1, 0), a3, voffA);
            PG8_WAIT_V(8); PG8_WAIT_L(0); PG8_BAR; PG8_MMA(1, 0, At, B0); PG8_MMA(1, 1, At, B1); PG8_BAR; PG8_SCHED;
        }
        if (wr == 0) PG8_BAR;
        E(acc, cur, wr, wc, fr, fq);
        if (!has_next) break;
#pragma unroll
        for (int a = 0; a < 2; ++a)
#pragma unroll
            for (int b = 0; b < 2; ++b)
#pragma unroll
                for (int m = 0; m < 4; ++m)
#pragma unroll
                    for (int n = 0; n < 2; ++n) acc[a][b][m][n] = (f32x4){0.f, 0.f, 0.f, 0.f};
        cur = nxt; cA = nA; cB = nB; ++ui;
        if (wr == 1) PG8_BAR;
    }
    PG8_WAIT_V(0);
    PG8_BAR;
#undef PG8_SA
#undef PG8_SB
#undef PG8_STAGE
#undef PG8_LDA
#undef PG8_LDB
#undef PG8_MMA
#undef PG8_WAIT_V
#undef PG8_WAIT_L
#undef PG8_BAR
#undef PG8_SCHED
}
}

template <int ACT>
DI void run_gemm(LAS unsigned char* lds, const bf16_t* A, const bf16_t* Bt, bf16_t* O, int M, int N, int K, const float* rs = nullptr) {
    pg8::Gemm g{A, Bt, M, N, K}; pg8::StaticOrder S; S.init(M, N, (int)gridDim.x, (int)blockIdx.x);
    pg8::EpiBf16<ACT> E{O, N, rs};
    pg8::gemm_phase<pg8::EpiBf16<ACT>>(lds, g, S, E);
}

DI int ina_srccol(int n) { return n < 3072 ? n : (n < 3328 ? n + 12 : (n < 3340 ? n - 256 : -1)); }
DI void transpose_item(const float* W, int K, int Nsrc, bf16_t* WT, int nblk, bool remap, LAS float* scr, int item, int lane, const float* gk = nullptr) {
    asm volatile("" : "+v"(lane));
    const int kb = item / nblk, nb = item % nblk, k0 = 64 * kb, n0 = 32 * nb;
    const int nn = n0 + (lane & 31); const int col = remap ? ina_srccol(nn) : nn;
#pragma unroll 8
    for (int i = 0; i < 32; ++i) { const int kk = 2 * i + (lane >> 5); float wv = col >= 0 ? W[(size_t)(k0 + kk) * Nsrc + col] : 0.f; if (gk) wv *= gk[k0 + kk]; scr[kk * 33 + (lane & 31)] = wv; }
    asm volatile("s_waitcnt lgkmcnt(0)" ::: "memory");
    const int c = lane & 7;
#pragma unroll
    for (int j = 0; j < 4; ++j) { const int n = (lane >> 3) + 8 * j; const LAS float* s = scr + (8 * c) * 33 + n;
        u32x4 o; o.x = pk2(s[0 * 33], s[1 * 33]); o.y = pk2(s[2 * 33], s[3 * 33]); o.z = pk2(s[4 * 33], s[5 * 33]); o.w = pk2(s[6 * 33], s[7 * 33]);
        *(u32x4*)(WT + (size_t)(n0 + n) * K + k0 + 8 * c) = o; }
    asm volatile("s_waitcnt lgkmcnt(0)" ::: "memory");
}
DI void rms_row_to_bf16(const float* xrow, const float* g, bf16_t* orow, int lane) {
    asm volatile("" : "+v"(lane));
    const f32x4* xr = (const f32x4*)xrow + lane; const f32x4* gr = (const f32x4*)g + lane;
    f32x4 v[4]; float s = 0.f;
#pragma unroll
    for (int j = 0; j < 4; ++j) { v[j] = xr[64 * j]; s += (v[j].x * v[j].x + v[j].y * v[j].y) + (v[j].z * v[j].z + v[j].w * v[j].w); }
    const float rstd = rsqrtf(wave_sum(s) * (1.f / DM) + EPSF);
    u32x2* o8 = (u32x2*)orow + lane;
#pragma unroll
    for (int j = 0; j < 4; ++j) { const f32x4 gg = gr[64 * j]; u32x2 o; o.x = pk2(v[j].x * rstd * gg.x, v[j].y * rstd * gg.y); o.y = pk2(v[j].z * rstd * gg.z, v[j].w * rstd * gg.w); o8[64 * j] = o; }
}
template <bool BASE_BF16, bool OUT_F32>
DI void resid_row(const void* basep, const bf16_t* yrow, const float* g1, void* outp, float* stat, int lane) {
    asm volatile("" : "+v"(lane));
    const u32x2* yr = (const u32x2*)yrow + lane;
    f32x4 y[4], b[4]; float s = 0.f;
#pragma unroll
    for (int j = 0; j < 4; ++j) { const u32x2 w = yr[64 * j]; y[j].x = __uint_as_float(w.x << 16); y[j].y = __uint_as_float(w.x & 0xffff0000u); y[j].z = __uint_as_float(w.y << 16); y[j].w = __uint_as_float(w.y & 0xffff0000u);
        s += (y[j].x * y[j].x + y[j].y * y[j].y) + (y[j].z * y[j].z + y[j].w * y[j].w); }
#pragma unroll
    for (int j = 0; j < 4; ++j) {
        if (BASE_BF16) { const u32x2 w = ((const u32x2*)basep + lane)[64 * j]; b[j].x = __uint_as_float(w.x << 16); b[j].y = __uint_as_float(w.x & 0xffff0000u); b[j].z = __uint_as_float(w.y << 16); b[j].w = __uint_as_float(w.y & 0xffff0000u); }
        else b[j] = ((const f32x4*)basep + lane)[64 * j]; }
    const float rstd = rsqrtf(wave_sum(s) * (1.f / DM) + EPSF);
    const f32x4* g1r = (const f32x4*)g1 + lane;
    float s2 = 0.f;
#pragma unroll
    for (int j = 0; j < 4; ++j) { const f32x4 gg = g1r[64 * j]; y[j] = b[j] + y[j] * rstd * gg; s2 += (y[j].x * y[j].x + y[j].y * y[j].y) + (y[j].z * y[j].z + y[j].w * y[j].w); }
#pragma unroll
    for (int j = 0; j < 4; ++j) {
        if (OUT_F32) ((f32x4*)outp + lane)[64 * j] = y[j];
        else { u32x2 o; o.x = pk2(y[j].x, y[j].y); o.y = pk2(y[j].z, y[j].w); ((u32x2*)outp + lane)[64 * j] = o; } }
    if (stat) {
        const float rstd2 = rsqrtf(wave_sum(s2) * (1.f / DM) + EPSF);
        if (lane == 0) *stat = rstd2;
    }
}

constexpr int IMG_LD = 136;
constexpr int IMG_BYTES = 64 * IMG_LD * 2;
constexpr int D1_REGION = IMG_BYTES + 1280;
template <int NR>
DI void conv_rows(const bf16_t* projc  , bool first_chunk, const float* cw  , LAS unsigned char* img, int lc, int r0) {
    float w[4][8];
#pragma unroll
    for (int i = 0; i < 4; ++i) { const f32x4 a = *(const f32x4*)(cw + i * 2304), b = *(const f32x4*)(cw + i * 2304 + 4);
        w[i][0] = a.x; w[i][1] = a.y; w[i][2] = a.z; w[i][3] = a.w; w[i][4] = b.x; w[i][5] = b.y; w[i][6] = b.z; w[i][7] = b.w; }
    float xm3[8], xm2[8], xm1[8], cur[8];
    const bool halo = !(first_chunk && r0 == 0);
    if (halo) { unpack8(*(const u32x4*)(projc + (long)(r0 - 3) * LDA_P), xm3); unpack8(*(const u32x4*)(projc + (long)(r0 - 2) * LDA_P), xm2); unpack8(*(const u32x4*)(projc + (long)(r0 - 1) * LDA_P), xm1); }
    else {
#pragma unroll
        for (int j = 0; j < 8; ++j) { xm3[j] = 0.f; xm2[j] = 0.f; xm1[j] = 0.f; } }
#pragma unroll
    for (int rr = 0; rr < NR; ++rr) {
        unpack8(*(const u32x4*)(projc + (long)(r0 + rr) * LDA_P), cur);
        float y[8];
#pragma unroll
        for (int j = 0; j < 8; ++j) { const float v = w[0][j] * xm3[j] + w[1][j] * xm2[j] + w[2][j] * xm1[j] + w[3][j] * cur[j]; y[j] = v * fast_rcp(1.f + fast_exp(-v)); xm3[j] = xm2[j]; xm2[j] = xm1[j]; xm1[j] = cur[j]; }
        *(LAS u32x4*)(img + (r0 + rr) * (IMG_LD * 2) + lc * 2) = pack8(y);
    }
}
DI float row_sumsq(const LAS unsigned char* img, int row) {
    float ss = 0.f;
#pragma unroll
    for (int c = 0; c < 16; ++c) { float f[8]; unpack8(*(const LAS u32x4*)(img + row * (IMG_LD * 2) + c * 16), f);
#pragma unroll
        for (int j = 0; j < 8; ++j) ss += f[j] * f[j]; }
    return ss;
}
DI int crow(int reg, int h) { return (reg & 3) + 8 * (reg >> 2) + 4 * h; }

DI void d1_unit(const Params& p, int ch, LAS unsigned char* wl, LAS float* tb, int lane) {
    asm volatile("" : "+v"(lane));
    const int h = ch % 6, bn = ch / 6, n = bn % NCH, b = bn / NCH;
    const long t0 = (long)b * SEQ + 64 * n;
    const bf16_t* proj = (const bf16_t*)(p.ws + WS_BIG);
    const int r = lane & 31, hh = lane >> 5;
    { const int cc = lane & 15, rg = lane >> 4; const int gcol = 768 + h * 128 + 8 * cc;
      conv_rows<16>(proj + t0 * LDA_P + gcol, n == 0, p.conv_w + gcol, wl, 8 * cc, 16 * rg); }
    asm volatile("s_waitcnt lgkmcnt(0)" ::: "memory");
    const float rk = rsqrtf(row_sumsq(wl, lane) + EPSF);
    const float bl = bf2f(proj[(t0 + lane) * LDA_P + 3328 + h]), al = bf2f(proj[(t0 + lane) * LDA_P + 3334 + h]);
    const float beta = 1.f / (1.f + __expf(-bl));
    const float xa = al + p.dt_bias[h];
    const float sp = xa > 20.f ? xa : log1pf(__expf(xa));
    float gc = -__expf(p.a_log[h]) * sp;
#pragma unroll
    for (int o = 1; o < 64; o <<= 1) { const float t = __shfl_up(gc, o); if (lane >= o) gc += t; }
    f32x16 t00, t01, t11;
#pragma unroll
    for (int i = 0; i < 16; ++i) { t00[i] = 0.f; t01[i] = 0.f; t11[i] = 0.f; }
#pragma unroll
    for (int s = 0; s < 8; ++s) {
        const bf16x8 f0 = *(const LAS bf16x8*)(wl + r * (IMG_LD * 2) + (16 * s + 8 * hh) * 2);
        const bf16x8 f1 = *(const LAS bf16x8*)(wl + (32 + r) * (IMG_LD * 2) + (16 * s + 8 * hh) * 2);
        t00 = MFMA32(f0, f0, t00); t01 = MFMA32(f0, f1, t01); t11 = MFMA32(f1, f1, t11);
    }
    bf16_t* KDc = (bf16_t*)(p.ws + WS_KD) + (size_t)ch * 8192;
    bf16_t* KRc = (bf16_t*)(p.ws + WS_T) + (size_t)ch * 8192;
#pragma unroll
    for (int k = 0; k < 16; ++k) { const int idx = lane + 64 * k, row = idx >> 4, c16 = idx & 15; *(u32x4*)(KRc + row * 128 + 8 * c16) = *(const LAS u32x4*)(wl + row * (IMG_LD * 2) + c16 * 16); }
    const float brk = beta * rk;
    const float sw = brk * __expf(gc);
    tb[lane] = rk; tb[64 + lane] = gc; tb[128 + lane] = beta; tb[192 + lane] = sw;
    LAS float* Lt = (LAS float*)wl;
    asm volatile("s_waitcnt lgkmcnt(0)" ::: "memory");
#pragma unroll
    for (int g = 0; g < 4; ++g) {
        f32x4 rk0 = *(const LAS f32x4*)(tb + 8 * g), rk1 = *(const LAS f32x4*)(tb + 8 * g + 4), rk2 = *(const LAS f32x4*)(tb + 32 + 8 * g), rk3 = *(const LAS f32x4*)(tb + 32 + 8 * g + 4);
        f32x4 gc0 = *(const LAS f32x4*)(tb + 64 + 8 * g), gc1 = *(const LAS f32x4*)(tb + 64 + 8 * g + 4), gc2 = *(const LAS f32x4*)(tb + 96 + 8 * g), gc3 = *(const LAS f32x4*)(tb + 96 + 8 * g + 4);
#pragma unroll
        for (int e = 0; e < 4; ++e) {
            const int reg = 4 * g + e;
            const float own0 = hh == 0 ? t00[reg] : t01[reg], snd = hh == 0 ? t01[reg] : t00[reg];
            const float ra = __shfl_xor(snd, 32), rb = __shfl_xor(t11[reg], 32);
            const int j0 = 8 * g + e, j1 = j0 + 4;
            const float l0 = hh == 0 ? own0 : ra, l1 = hh == 1 ? own0 : ra, l2 = hh == 1 ? rb : 0.f, l3 = hh == 1 ? t11[reg] : 0.f;
            const float v0 = l0 * brk * rk0[e] * __expf(gc - gc0[e]);
            const float v1 = l1 * brk * rk1[e] * __expf(gc - gc1[e]);
            const float v2 = l2 * brk * rk2[e] * __expf(gc - gc2[e]);
            const float v3 = l3 * brk * rk3[e] * __expf(gc - gc3[e]);
            Lt[j0 * 64 + lane] = (j0 < lane) ? v0 : 0.f;
            Lt[j1 * 64 + lane] = (j1 < lane) ? v1 : 0.f;
            Lt[(32 + j0) * 64 + lane] = (32 + j0 < lane) ? v2 : 0.f;
            Lt[(32 + j1) * 64 + lane] = (32 + j1 < lane) ? v3 : 0.f;
        }
    }
    asm volatile("s_waitcnt lgkmcnt(0)" ::: "memory");
    float X[64];
#pragma unroll
    for (int i = 0; i < 64; ++i) X[i] = 0.f;
#pragma unroll
    for (int i = 63; i >= 0; --i) {
        const LAS float* rp = Lt + i * 64;
        if (i < 63) asm volatile("" : "+v"(rp) : "v"(X[i + 1]));
        float acc = -rp[lane];
#pragma unroll
        for (int j4 = ((i + 1) & ~3); j4 < 64; j4 += 4) {
            if (j4 == 32 && i < 28) asm volatile("" : "+v"(rp) : "v"(acc));
            const f32x4 u = *(const LAS f32x4*)(rp + j4);
            acc -= u.x * X[j4]; acc -= u.y * X[j4 + 1]; acc -= u.z * X[j4 + 2]; acc -= u.w * X[j4 + 3]; }
        X[i] = acc;
    }
    u32x4 mineU[4], recvU[4], mineW[4], recvW[4];
#pragma unroll
    for (int s = 0; s < 4; ++s) { u32x4 pu[2], pw[2];
#pragma unroll
        for (int hf = 0; hf < 2; ++hf) { const int c8 = 2 * s + hf; float fu[8], fw[8];
            const f32x4 b0 = *(const LAS f32x4*)(tb + 128 + 8 * c8), b1 = *(const LAS f32x4*)(tb + 128 + 8 * c8 + 4), s0 = *(const LAS f32x4*)(tb + 192 + 8 * c8), s1 = *(const LAS f32x4*)(tb + 192 + 8 * c8 + 4);
#pragma unroll
            for (int j = 0; j < 4; ++j) { const float x0 = X[8 * c8 + j] + ((lane == 8 * c8 + j) ? 1.f : 0.f), x1 = X[8 * c8 + 4 + j] + ((lane == 8 * c8 + 4 + j) ? 1.f : 0.f);
                fu[j] = x0 * b0[j]; fu[4 + j] = x1 * b1[j]; fw[j] = x0 * s0[j]; fw[4 + j] = x1 * s1[j]; }
            pu[hf] = pack8(fu); pw[hf] = pack8(fw); }
        asm volatile("" ::: "memory");
#pragma unroll
        for (int e = 0; e < 4; ++e) { mineU[s][e] = hh ? pu[1][e] : pu[0][e]; mineW[s][e] = hh ? pw[1][e] : pw[0][e];
            const unsigned su = hh ? pu[0][e] : pu[1][e], sw_ = hh ? pw[0][e] : pw[1][e];
            recvU[s][e] = (unsigned)__shfl_xor((int)su, 32); recvW[s][e] = (unsigned)__shfl_xor((int)sw_, 32); }
    }
    ((float*)(p.ws + WS_GC))[(size_t)ch * 64 + lane] = gc;
    asm volatile("s_waitcnt vmcnt(0) lgkmcnt(0)" ::: "memory");
    asm volatile("" : "+v"(lane));
    const int r2 = lane & 31, hh2 = lane >> 5;
#define r r2
#define hh hh2
    {
        const float gl = tb[64 + 63];
#pragma unroll 4
        for (int k = 0; k < 16; ++k) { const int idx = lane + 64 * k, row = idx >> 4, c16 = idx & 15;
            const u32x4 v = *(const u32x4*)(KRc + row * 128 + 8 * c16);
            *(LAS u32x4*)(wl + row * (IMG_LD * 2) + c16 * 16) = v;
            float f[8]; unpack8(v, f); const float sc = tb[row] * __expf(gl - tb[64 + row]);
#pragma unroll
            for (int j = 0; j < 8; ++j) f[j] *= sc;
            *(u32x4*)(KDc + row * 128 + 8 * c16) = pack8(f); }
    }
    const int trrow = (lane & 15) >> 2, trcb = 16 * ((lane >> 4) & 1) + 4 * (lane & 3);
#define D1_PASS(MINE, RECV, DSTOFF) do { \
        asm volatile("s_waitcnt lgkmcnt(0)" ::: "memory"); \
        bf16_t* dstb = (bf16_t*)((unsigned char*)p.out + (DSTOFF)) + (size_t)ch * 8192; \
        _Pragma("unroll 1") for (int mt = 0; mt < 2; ++mt) { \
            bf16x8 bt[4]; \
            _Pragma("unroll") for (int s = 0; s < 4; ++s) { u32x4 t; _Pragma("unroll") for (int e = 0; e < 4; ++e) t[e] = (mt == hh) ? MINE[s][e] : RECV[s][e]; bt[s] = __builtin_bit_cast(bf16x8, t); } \
            _Pragma("unroll") for (int nt = 0; nt < 4; ++nt) { \
                f32x16 a; \
                _Pragma("unroll") for (int i = 0; i < 16; ++i) a[i] = 0.f; \
                _Pragma("unroll") for (int s = 0; s < 4; ++s) { const int row0 = 16 * s + 8 * hh + trrow, cb = 32 * nt + trcb; \
                    const bf16x8 av = cat4(tr_read(wl + row0 * (IMG_LD * 2) + cb * 2), tr_read(wl + (row0 + 4) * (IMG_LD * 2) + cb * 2)); \
                    a = MFMA32(av, bt[s], a); } \
                bf16_t* d = dstb + (32 * mt + r) * 128 + 32 * nt + 4 * hh; \
                _Pragma("unroll") for (int g = 0; g < 4; ++g) { u32x2 o; o.x = pk2(a[4 * g], a[4 * g + 1]); o.y = pk2(a[4 * g + 2], a[4 * g + 3]); *(u32x2*)(d + 8 * g) = o; } \
            } \
        } } while (0)
    D1_PASS(mineW, recvW, DO_W);
    { const int cc = lane & 15, rg = lane >> 4; const int gcol = 1536 + h * 128 + 8 * cc;
      conv_rows<16>(proj + t0 * LDA_P + gcol, n == 0, p.conv_w + gcol, wl, 8 * cc, 16 * rg); }
    D1_PASS(mineU, recvU, DO_U);
#undef D1_PASS
    { const int cc = lane & 15, rg = lane >> 4; const int gcol = h * 128 + 8 * cc;
      conv_rows<16>(proj + t0 * LDA_P + gcol, n == 0, p.conv_w + gcol, wl, 8 * cc, 16 * rg); }
    asm volatile("s_waitcnt lgkmcnt(0)" ::: "memory");
    const float rqv = rsqrtf(row_sumsq(wl, lane) + EPSF) * 0.08838834764831845f;
    tb[256 + lane] = rqv;
    asm volatile("s_waitcnt lgkmcnt(0)" ::: "memory");
    {
        bf16_t* QDc = (bf16_t*)(p.ws + WS_QD) + (size_t)ch * 8192;
#pragma unroll 4
        for (int k = 0; k < 16; ++k) { const int idx = lane + 64 * k, row = idx >> 4, c16 = idx & 15;
            float f[8]; unpack8(*(const LAS u32x4*)(wl + row * (IMG_LD * 2) + c16 * 16), f);
            const float sc = tb[256 + row] * __expf(tb[64 + row]);
#pragma unroll
            for (int j = 0; j < 8; ++j) f[j] *= sc;
            *(u32x4*)(QDc + row * 128 + 8 * c16) = pack8(f); }
    }
    {
        f32x16 a00, a10, a11;
#pragma unroll
        for (int i = 0; i < 16; ++i) { a00[i] = 0.f; a10[i] = 0.f; a11[i] = 0.f; }
#pragma unroll
        for (int s = 0; s < 8; ++s) {
            const bf16x8 fq0 = *(const LAS bf16x8*)(wl + r * (IMG_LD * 2) + (16 * s + 8 * hh) * 2);
            const bf16x8 fq1 = *(const LAS bf16x8*)(wl + (32 + r) * (IMG_LD * 2) + (16 * s + 8 * hh) * 2);
            const bf16x8 fk0 = *(const bf16x8*)(KRc + r * 128 + 16 * s + 8 * hh);
            const bf16x8 fk1 = *(const bf16x8*)(KRc + (32 + r) * 128 + 16 * s + 8 * hh);
            a00 = MFMA32(fk0, fq0, a00); a10 = MFMA32(fk0, fq1, a10); a11 = MFMA32(fk1, fq1, a11);
        }
        bf16_t* AIc = (bf16_t*)((unsigned char*)p.out + DO_AI) + (size_t)ch * 4096;
#pragma unroll
        for (int it = 0; it < 2; ++it) {
            const int i = 32 * it + r; const float rqi = tb[256 + i], gci = tb[64 + i];
#pragma unroll
            for (int jt = 0; jt < 2; ++jt)
#pragma unroll
                for (int g = 0; g < 4; ++g) { float o[4];
                    const f32x4 rkj = *(const LAS f32x4*)(tb + 32 * jt + 8 * g + 4 * hh), gcj = *(const LAS f32x4*)(tb + 64 + 32 * jt + 8 * g + 4 * hh);
#pragma unroll
                    for (int e = 0; e < 4; ++e) { const int j = 32 * jt + 8 * g + 4 * hh + e;
                        const float av = (it == 0) ? (jt == 0 ? a00[4 * g + e] : 0.f) : (jt == 0 ? a10[4 * g + e] : a11[4 * g + e]);
                        const float v = av * rqi * rkj[e] * __expf(gci - gcj[e]); o[e] = (j <= i) ? v : 0.f; }
                    u32x2 w; w.x = pk2(o[0], o[1]); w.y = pk2(o[2], o[3]); *(u32x2*)(AIc + i * 64 + 32 * jt + 8 * g + 4 * hh) = w; }
        }
    }
    asm volatile("s_waitcnt lgkmcnt(0)" ::: "memory");
#undef r
#undef hh
}

constexpr int D2_AIMG_LD = 72;
constexpr int D2_UOFF = 3 * IMG_BYTES, D2_AOFF = D2_UOFF + 64 * 128 * 2;
constexpr int D2_BUF = D2_AOFF + 64 * D2_AIMG_LD * 2;
DI void d2_unit(const Params& p, int bh, LAS unsigned char* lds, int tid) {
    asm volatile("" : "+v"(tid));
    const int b = bh / 6, h = bh % 6;
    const int lane = tid & 63, wid = __builtin_amdgcn_readfirstlane(tid >> 6), col = lane & 15, quad = lane >> 4, e0 = 16 * wid;
    const bf16_t* proj = (const bf16_t*)(p.ws + WS_BIG);
    bf16_t* mix = (bf16_t*)(p.ws + WS_XN);
    const bf16_t* Ug = (const bf16_t*)((unsigned char*)p.out + DO_U); const bf16_t* Wg = (const bf16_t*)((unsigned char*)p.out + DO_W); const bf16_t* Ag = (const bf16_t*)((unsigned char*)p.out + DO_AI);
    const bf16_t* QDg = (const bf16_t*)(p.ws + WS_QD); const bf16_t* KDg = (const bf16_t*)(p.ws + WS_KD);
    const float* gcb = (const float*)(p.ws + WS_GC);
    LAS float* ssx = (LAS float*)(lds + 2 * D2_BUF);
    const float og = p.onorm[e0 + col];
    f32x4 S[8];
#pragma unroll
    for (int i = 0; i < 8; ++i) S[i] = (f32x4){0.f, 0.f, 0.f, 0.f};
    u32x4 pre[9];
#define D2_LOAD(chv) do { _Pragma("unroll") for (int k = 0; k < 9; ++k) { const int ci = tid + 512 * k; \
        if (k < 8) { const int arr = k >> 1; const unsigned voff = (unsigned)(ci & 1023) * 16u; const char* sb = (const char*)(arr == 0 ? Wg : (arr == 1 ? QDg : (arr == 2 ? KDg : Ug))) + (size_t)(chv) * 16384; pre[k] = *(const u32x4*)(sb + voff); } \
        else { const unsigned voff = (unsigned)(ci - 4096) * 16u; const char* sb = (const char*)Ag + (size_t)(chv) * 8192; pre[k] = *(const u32x4*)(sb + voff); } } } while (0)
#define D2_STORE(bufp) do { _Pragma("unroll") for (int k = 0; k < 9; ++k) { const int ci = tid + 512 * k; \
        if (k < 6) { const int arr = k >> 1, rem = ci & 1023, row = rem >> 4, c16 = rem & 15; *(LAS u32x4*)((bufp) + arr * IMG_BYTES + row * (IMG_LD * 2) + c16 * 16) = pre[k]; } \
        else if (k < 8) { *(LAS u32x4*)((bufp) + D2_UOFF + (ci - 3072) * 16) = pre[k]; } \
        else { const int rem = ci - 4096, row = rem >> 3, c8 = rem & 7; *(LAS u32x4*)((bufp) + D2_AOFF + row * (D2_AIMG_LD * 2) + c8 * 16) = pre[k]; } } } while (0)
    { const int ch0 = (b * NCH) * 6 + h; D2_LOAD(ch0); D2_STORE(lds); }
    __syncthreads();
    for (int n = 0; n < NCH; ++n) {
        const int ch = (b * NCH + n) * 6 + h; const long t0 = (long)b * SEQ + 64 * n;
        LAS unsigned char* buf = lds + (n & 1) * D2_BUF;
        if (n + 1 < NCH) { const int chn = ch + 6; D2_LOAD(chn); }
        u32x4 gq[2];
#pragma unroll
        for (int k = 0; k < 2; ++k) { const int idx = tid + 512 * k, row = idx >> 4, c16 = idx & 15; const char* sb = (const char*)(proj + t0 * LDA_P + 2304 + h * 128); gq[k] = *(const u32x4*)(sb + (unsigned)(row * (LDA_P * 2) + c16 * 16)); }
        const float dc = __expf(gcb[(size_t)ch * 64 + 63]);
        bf16x8 Sb[4];
#pragma unroll
        for (int ks = 0; ks < 4; ++ks) { u32x4 w; w.x = pk2(S[2 * ks][0], S[2 * ks][1]); w.y = pk2(S[2 * ks][2], S[2 * ks][3]); w.z = pk2(S[2 * ks + 1][0], S[2 * ks + 1][1]); w.w = pk2(S[2 * ks + 1][2], S[2 * ks + 1][3]); Sb[ks] = __builtin_bit_cast(bf16x8, w); }
        f32x4 vn[4], o[4];
#pragma unroll
        for (int mt = 0; mt < 4; ++mt) {
            f32x4 a1 = (f32x4){0.f, 0.f, 0.f, 0.f}, a2 = (f32x4){0.f, 0.f, 0.f, 0.f};
#pragma unroll
            for (int ks = 0; ks < 4; ++ks) {
                const int off = (16 * mt + col) * (IMG_LD * 2) + (32 * ks + 4 * quad) * 2;
                const bf16x8 fw = cat4(*(const LAS s16x4*)(buf + off), *(const LAS s16x4*)(buf + off + 32));
                const bf16x8 fq = cat4(*(const LAS s16x4*)(buf + IMG_BYTES + off), *(const LAS s16x4*)(buf + IMG_BYTES + off + 32));
                a1 = MFMA16(fw, Sb[ks], a1); a2 = MFMA16(fq, Sb[ks], a2);
            }
#pragma unroll
            for (int j = 0; j < 4; ++j) vn[mt][j] = bf2f(*(const LAS bf16_t*)(buf + D2_UOFF + ((16 * mt + 4 * quad + j) * 128 + e0 + col) * 2)) - a1[j];
            o[mt] = a2;
        }
        bf16x8 Vb[2];
#pragma unroll
        for (int ks = 0; ks < 2; ++ks) { u32x4 w; w.x = pk2(vn[2 * ks][0], vn[2 * ks][1]); w.y = pk2(vn[2 * ks][2], vn[2 * ks][3]); w.z = pk2(vn[2 * ks + 1][0], vn[2 * ks + 1][1]); w.w = pk2(vn[2 * ks + 1][2], vn[2 * ks + 1][3]); Vb[ks] = __builtin_bit_cast(bf16x8, w); }
#pragma unroll
        for (int mt = 0; mt < 4; ++mt)
#pragma unroll
            for (int ks = 0; ks < 2; ++ks) {
                const int off = D2_AOFF + (16 * mt + col) * (D2_AIMG_LD * 2) + (32 * ks + 4 * quad) * 2;
                const bf16x8 fa = cat4(*(const LAS s16x4*)(buf + off), *(const LAS s16x4*)(buf + off + 32));
                o[mt] = MFMA16(fa, Vb[ks], o[mt]);
            }
#pragma unroll
        for (int dt = 0; dt < 8; ++dt) {
            S[dt] = S[dt] * dc;
#pragma unroll
            for (int ks = 0; ks < 2; ++ks) {
                const int off = 2 * IMG_BYTES + (32 * ks + 4 * quad + ((lane & 15) >> 2)) * (IMG_LD * 2) + (16 * dt + 4 * (lane & 3)) * 2;
                const bf16x8 fk = cat4(tr_read(buf + off), tr_read(buf + off + 16 * (IMG_LD * 2)));
                S[dt] = MFMA16(fk, Vb[ks], S[dt]);
            }
        }
        LAS float* sx = ssx + (n & 1) * 512;
#pragma unroll
        for (int mt = 0; mt < 4; ++mt)
#pragma unroll
            for (int j = 0; j < 4; ++j) { float s = o[mt][j] * o[mt][j]; s = row16_sum(s);
                if (col == 0) sx[(16 * mt + 4 * quad + j) * 8 + wid] = s; }
        asm volatile("s_waitcnt lgkmcnt(0)\n\ts_barrier" ::: "memory");
#pragma unroll
        for (int mt = 0; mt < 4; ++mt)
#pragma unroll
            for (int j = 0; j < 4; ++j) { const int row = 16 * mt + 4 * quad + j;
                const f32x4 s0 = *(const LAS f32x4*)(sx + row * 8), s1 = *(const LAS f32x4*)(sx + row * 8 + 4);
                const float tot = (s0.x + s0.y) + (s0.z + s0.w) + (s1.x + s1.y) + (s1.z + s1.w);
                const float rstd = rsqrtf(tot * (1.f / 128.f) + EPSF);
                *(LAS bf16_t*)(buf + row * (IMG_LD * 2) + (e0 + col) * 2) = (bf16_t)(pk2(o[mt][j] * rstd * og, 0.f) & 0xffffu); }
        if (n + 1 < NCH) { LAS unsigned char* nb = lds + ((n + 1) & 1) * D2_BUF; D2_STORE(nb); }
        asm volatile("s_waitcnt lgkmcnt(0)\n\ts_barrier" ::: "memory");
#pragma unroll
        for (int k = 0; k < 2; ++k) { const int idx = tid + 512 * k, row = idx >> 4, c16 = idx & 15;
            float fo[8], fg[8]; unpack8(*(const LAS u32x4*)(buf + row * (IMG_LD * 2) + c16 * 16), fo); unpack8(gq[k], fg);
#pragma unroll
            for (int j = 0; j < 8; ++j) fo[j] *= fg[j] * fast_rcp(1.f + fast_exp(-fg[j]));
            char* db = (char*)(mix + t0 * DM + h * 128); *(u32x4*)(db + (unsigned)(row * (DM * 2) + c16 * 16)) = pack8(fo); }
    }
    __syncthreads();
#undef D2_LOAD
#undef D2_STORE
}

constexpr int KV_LD = 72;
DI f32x16 qk_tile(const LAS unsigned char* Kimg, int key0, const bf16x8* qf, int r, int hh) {
    f32x16 x;
#pragma unroll
    for (int i = 0; i < 16; ++i) x[i] = 0.f;
#pragma unroll
    for (int s = 0; s < 4; ++s) { const bf16x8 kf = *(const LAS bf16x8*)(Kimg + (key0 + r) * (KV_LD * 2) + (16 * s + 8 * hh) * 2); x = MFMA32(kf, qf[s], x); }
    return x;
}
DI void pv_tile(const LAS unsigned char* Vimg, int key0, const f32x16& pr, f32x16* O, int lane) {
    const int hh = lane >> 5;
#pragma unroll
    for (int s = 0; s < 2; ++s) {
        u32x4 w; w.x = pk2(pr[8 * s], pr[8 * s + 1]); w.y = pk2(pr[8 * s + 2], pr[8 * s + 3]); w.z = pk2(pr[8 * s + 4], pr[8 * s + 5]); w.w = pk2(pr[8 * s + 6], pr[8 * s + 7]);
        const bf16x8 pb = __builtin_bit_cast(bf16x8, w);
#pragma unroll
        for (int dt = 0; dt < 2; ++dt) {
            const int row0 = key0 + 16 * s + 4 * hh + ((lane & 15) >> 2), cb = 32 * dt + 16 * ((lane >> 4) & 1) + 4 * (lane & 3);
            const bf16x8 va = cat4(tr_read(Vimg + row0 * (KV_LD * 2) + cb * 2), tr_read(Vimg + (row0 + 8) * (KV_LD * 2) + cb * 2));
            O[dt] = MFMA32(va, pb, O[dt]);
        }
    }
}

DI void xattn_unit(const Params& p, int unit, int layer, const bf16_t* proj, int ldp, int qcol, LAS unsigned char* lds, int tid) {
    asm volatile("" : "+v"(tid));
    const int qb = unit & 7, xh = (unit >> 3) & 3, b = unit >> 5;
    const int lane = tid & 63, wid = __builtin_amdgcn_readfirstlane(tid >> 6), r = lane & 31, hh = lane >> 5;
    LAS unsigned char* Kimg = lds; LAS unsigned char* Vimg = lds + 256 * KV_LD * 2;
    const bf16_t* mkv = (const bf16_t*)(p.ws + WS_MEMKV) + (size_t)b * NMEM * 1024 + layer * 512 + xh * 64;
#pragma unroll
    for (int k = 0; k < 4; ++k) { const int ci = tid + 512 * k, key = ci >> 3, c8 = ci & 7;
        *(LAS u32x4*)(Kimg + key * (KV_LD * 2) + c8 * 16) = *(const u32x4*)(mkv + (size_t)key * 1024 + c8 * 8);
        *(LAS u32x4*)(Vimg + key * (KV_LD * 2) + c8 * 16) = *(const u32x4*)(mkv + (size_t)key * 1024 + 256 + c8 * 8); }
    const long tq = (long)b * SEQ + 256 * qb + 32 * wid + r;
    bf16x8 qf[4];
#pragma unroll
    for (int s = 0; s < 4; ++s) qf[s] = *(const bf16x8*)(proj + tq * ldp + qcol + xh * 64 + 16 * s + 8 * hh);
    __syncthreads();
    float m = -3.0e38f;
#pragma unroll 1
    for (int kt = 0; kt < 8; ++kt) { const f32x16 x = qk_tile(Kimg, 32 * kt, qf, r, hh);
#pragma unroll
        for (int i = 0; i < 16; ++i) m = fmaxf(m, x[i]); }
    m = fmaxf(m, __shfl_xor(m, 32));
    const float c2 = 0.125f * 1.4426950408889634f; const float mb = m * c2;
    f32x16 O[2]; float l = 0.f;
#pragma unroll
    for (int i = 0; i < 16; ++i) { O[0][i] = 0.f; O[1][i] = 0.f; }
#pragma unroll 1
    for (int kt = 0; kt < 8; ++kt) { f32x16 x = qk_tile(Kimg, 32 * kt, qf, r, hh);
#pragma unroll
        for (int i = 0; i < 16; ++i) { x[i] = __builtin_amdgcn_exp2f(x[i] * c2 - mb); l += x[i]; }
        pv_tile(Vimg, 32 * kt, x, O, lane); }
    l += __shfl_xor(l, 32);
    const float il = 1.f / l;
    bf16_t* dst = (bf16_t*)(p.ws + WS_XN) + tq * DM + 768 + xh * 64 + 4 * hh;
#pragma unroll
    for (int dt = 0; dt < 2; ++dt)
#pragma unroll
        for (int g = 0; g < 4; ++g) { u32x2 w; w.x = pk2(O[dt][4 * g] * il, O[dt][4 * g + 1] * il); w.y = pk2(O[dt][4 * g + 2] * il, O[dt][4 * g + 3] * il); *(u32x2*)(dst + 32 * dt + 8 * g) = w; }
    __syncthreads();
}

DI void sb_unit(const Params& p, int bhd, int qb, LAS unsigned char* lds, int tid) {
    asm volatile("" : "+v"(tid));
    const int b = bhd / 12, hd = bhd % 12;
    const int lane = tid & 63, wid = __builtin_amdgcn_readfirstlane(tid >> 6), r = lane & 31, hh = lane >> 5;
    const bf16_t* proj = (const bf16_t*)(p.ws + WS_BIG);
    const long tb = (long)b * SEQ;
    const int wblk = wid < 4 ? wid : 11 - wid;
    const int tq = 256 * qb + 32 * wblk + r;
    const int qhi = 256 * qb + 32 * wblk + 32;
    bf16x8 qf[4];
#pragma unroll
    for (int s = 0; s < 4; ++s) { float f[8]; unpack8(*(const u32x4*)(proj + (tb + tq) * LDB_P + hd * 64 + 16 * s + 8 * hh), f);
#pragma unroll
        for (int j = 0; j < 8; ++j) f[j] *= 0.125f * 1.4426950408889634f;
        qf[s] = __builtin_bit_cast(bf16x8, pack8(f)); }
    const int NT = 2 * (qb + 1);
    const int lkey = tid >> 3, lc8 = tid & 7;
    const bf16_t* kbase = proj + tb * LDB_P + 768 + hd * 64 + lc8 * 8; const bf16_t* vbase = kbase + 768;
    constexpr int SBUF = 2 * 128 * KV_LD * 2;
    u32x4 rk0, rk1, rv0, rv1;
#define SB_LOAD(t) do { const size_t o0 = (size_t)(128 * (t) + lkey) * LDB_P, o1 = o0 + (size_t)64 * LDB_P; rk0 = *(const u32x4*)(kbase + o0); rk1 = *(const u32x4*)(kbase + o1); rv0 = *(const u32x4*)(vbase + o0); rv1 = *(const u32x4*)(vbase + o1); } while (0)
#define SB_STORE(bufp) do { *(LAS u32x4*)((bufp) + lkey * (KV_LD * 2) + lc8 * 16) = rk0; *(LAS u32x4*)((bufp) + (64 + lkey) * (KV_LD * 2) + lc8 * 16) = rk1; \
        *(LAS u32x4*)((bufp) + 128 * KV_LD * 2 + lkey * (KV_LD * 2) + lc8 * 16) = rv0; *(LAS u32x4*)((bufp) + 128 * KV_LD * 2 + (64 + lkey) * (KV_LD * 2) + lc8 * 16) = rv1; } while (0)
#define SB_LOADK(kloc) do { _Pragma("unroll") for (int s = 0; s < 4; ++s) kf[s] = *(const LAS bf16x8*)(Kimg + ((kloc) + r) * (KV_LD * 2) + (16 * s + 8 * hh) * 2); } while (0)
    SB_LOAD(NT - 1);
    f32x16 O[2];
#pragma unroll
    for (int i = 0; i < 16; ++i) { O[0][i] = 0.f; O[1][i] = 0.f; }
    float R = 1.f;
    SB_STORE(lds);
    if (NT >= 2) SB_LOAD(NT - 2);
    asm volatile("s_waitcnt lgkmcnt(0)\n\ts_barrier" ::: "memory");
    int cur = 0;
    const int vrow = 4 * hh + ((lane & 15) >> 2), vcb = 16 * ((lane >> 4) & 1) + 4 * (lane & 3);
#pragma unroll 1
    for (int j = NT - 1; j >= 0; --j) {
        const LAS unsigned char* Kimg = lds + cur * SBUF; const LAS unsigned char* Vimg = Kimg + 128 * KV_LD * 2;
        int sub0 = (qhi - 2 - 128 * j) >> 5; sub0 = sub0 > 3 ? 3 : sub0;
        if (sub0 >= 0) {
            bf16x8 kf[4];
            SB_LOADK(32 * sub0);
#pragma unroll 1
            for (int sub = sub0; sub >= 0; --sub) {
                const int key0 = 128 * j + 32 * sub;
                f32x16 x;
#pragma unroll
                for (int i = 0; i < 16; ++i) x[i] = 0.f;
#pragma unroll
                for (int s = 0; s < 4; ++s) x = MFMA32(kf[s], qf[s], x);
                if (sub > 0) SB_LOADK(32 * (sub - 1));
                s16x4 vf[2][2][2];
#pragma unroll
                for (int s = 0; s < 2; ++s)
#pragma unroll
                    for (int dt = 0; dt < 2; ++dt)
#pragma unroll
                        for (int hf = 0; hf < 2; ++hf) vf[s][dt][hf] = tr_read(Vimg + (32 * sub + 16 * s + 8 * hf + vrow) * (KV_LD * 2) + (32 * dt + vcb) * 2);
                __builtin_amdgcn_sched_barrier(0);
                float cc[16];
#pragma unroll
                for (int i = 0; i < 16; ++i) cc[i] = fast_rcp(1.f + __builtin_amdgcn_exp2f(x[i]));
                if (key0 + 31 >= qhi - 32) {
#pragma unroll
                    for (int i = 0; i < 16; ++i) { const int key = key0 + crow(i, hh); if (key >= tq) cc[i] = 1.f; }
                }
                float G[4], Go[4];
#pragma unroll
                for (int g = 0; g < 4; ++g) { const float p3 = cc[4 * g + 3], p2 = p3 * cc[4 * g + 2], p1 = p2 * cc[4 * g + 1], p0 = p1 * cc[4 * g];
                    x[4 * g + 3] = 1.f - p3; x[4 * g + 2] = p3 - p2; x[4 * g + 1] = p2 - p1; x[4 * g] = p1 - p0; G[g] = p0; }
#pragma unroll
                for (int g = 0; g < 4; ++g) { auto rr = __builtin_amdgcn_permlane32_swap(__float_as_uint(G[g]), __float_as_uint(G[g]), false, false);
                    G[g] = __uint_as_float(rr[0]); Go[g] = __uint_as_float(rr[1]); }
                float suf = R;
#pragma unroll
                for (int g = 3; g >= 0; --g) {
                    const float F = hh == 0 ? suf * Go[g] : suf;
#pragma unroll
                    for (int e = 0; e < 4; ++e) x[4 * g + e] *= F;
                    suf *= G[g] * Go[g];
                }
                R = suf;
#pragma unroll
                for (int s = 0; s < 2; ++s) {
                    u32x4 w; w.x = pk2(x[8 * s], x[8 * s + 1]); w.y = pk2(x[8 * s + 2], x[8 * s + 3]); w.z = pk2(x[8 * s + 4], x[8 * s + 5]); w.w = pk2(x[8 * s + 6], x[8 * s + 7]);
                    const bf16x8 pb = __builtin_bit_cast(bf16x8, w);
#pragma unroll
                    for (int dt = 0; dt < 2; ++dt) O[dt] = MFMA32(cat4(vf[s][dt][0], vf[s][dt][1]), pb, O[dt]);
                }
            }
        }
        if (j >= 1) SB_STORE(lds + (cur ^ 1) * SBUF);
        if (j >= 2) SB_LOAD(j - 2);
        asm volatile("s_waitcnt lgkmcnt(0)\n\ts_barrier" ::: "memory");
        cur ^= 1;
    }
#undef SB_LOAD
#undef SB_STORE
#undef SB_LOADK
    bf16_t* dst = (bf16_t*)(p.ws + WS_XN) + (tb + tq) * DM + hd * 64 + 4 * hh;
#pragma unroll
    for (int dt = 0; dt < 2; ++dt)
#pragma unroll
        for (int g = 0; g < 4; ++g) { u32x2 w; w.x = pk2(O[dt][4 * g], O[dt][4 * g + 1]); w.y = pk2(O[dt][4 * g + 2], O[dt][4 * g + 3]); *(u32x2*)(dst + 32 * dt + 8 * g) = w; }
}

#define XB_TMO      128
#define XB_XCNT(j)  (256  + 64 * (j))
#define XB_XSUB(j)  (1280 + 64 * (j))
#define XB_XGEN(j)  (2304 + 64 * (j))
#define XB_TOP      3328
#define XB_TOPGEN   3392
#define XCD_BAR_WORDS 3456
#define XB_SPIN_CAP (1u << 18)
DI unsigned xb_ld(unsigned* p)              { return __hip_atomic_load(p, __ATOMIC_RELAXED, __HIP_MEMORY_SCOPE_AGENT); }
DI unsigned xb_add(unsigned* p, unsigned v) { return __hip_atomic_fetch_add(p, v, __ATOMIC_RELAXED, __HIP_MEMORY_SCOPE_AGENT); }
DI unsigned xb_xcc_id() { return (unsigned)__builtin_amdgcn_s_getreg((3 << 11) | 20) & 0xFu; }
#define XB_SPIN(cond, bar) do { unsigned _sp = 0; while (cond) { __builtin_amdgcn_s_sleep(1); \
    if ((++_sp & 255u) == 0u) { if (xb_ld(&(bar)[XB_TMO])) break; if (_sp > XB_SPIN_CAP) { atomicAdd(&(bar)[XB_TMO], 1u); break; } } } } while (0)
struct XcdBarrier { unsigned* bar; unsigned x; volatile LAS unsigned* st; };
DI XcdBarrier xcd_barrier_post(unsigned* bar, volatile LAS unsigned* st) {
    XcdBarrier b; b.bar = bar; b.x = xb_xcc_id(); b.st = st;
    if (threadIdx.x == 0) (void)xb_add(&bar[XB_XCNT(b.x)], 1u);
    return b;
}
DI void xcd_barrier_complete(unsigned* bar, unsigned x, unsigned& nloc, unsigned& nx) {
    const unsigned G = gridDim.x * gridDim.y * gridDim.z;
    unsigned sum, cnt, mine, sp = 0u;
    for (;;) {
        sum = 0u; cnt = 0u; mine = 0u;
#pragma unroll
        for (unsigned j = 0; j < 16; ++j) { const unsigned c = xb_ld(&bar[XB_XCNT(j)]); sum += c; cnt += (c > 0u) ? 1u : 0u; mine = (j == x) ? c : mine; }
        if (sum == G) break;
        __builtin_amdgcn_s_sleep(1);
        if ((++sp & 255u) == 0u) { if (xb_ld(&bar[XB_TMO])) break; if (sp > XB_SPIN_CAP) { atomicAdd(&bar[XB_TMO], 1u); break; } }
    }
    nloc = mine > 0u ? mine : 1u; nx = cnt > 0u ? cnt : 1u;
}
DI void xcd_barrier(const XcdBarrier& b) {
    asm volatile("s_waitcnt vmcnt(0)" ::: "memory");
    __syncthreads();
    if (threadIdx.x == 0) {
        unsigned* bar = b.bar;
        __builtin_amdgcn_s_waitcnt(0);
        unsigned nloc = b.st[0], nx = b.st[1];
        if (nloc == 0u) { xcd_barrier_complete(bar, b.x, nloc, nx); b.st[0] = nloc; b.st[1] = nx; }
        const unsigned old = xb_add(&bar[XB_XSUB(b.x)], 1u);
        const unsigned gen = old / nloc;
        if (old + 1u == (gen + 1u) * nloc) {
            __builtin_amdgcn_fence(__ATOMIC_RELEASE, "agent");
            asm volatile("s_waitcnt vmcnt(0)" ::: "memory");
            const unsigned og = xb_add(&bar[XB_TOP], 1u);
            const unsigned tg = og / nx;
            if (og + 1u == (tg + 1u) * nx) xb_add(&bar[XB_TOPGEN], 1u);
            else XB_SPIN(xb_ld(&bar[XB_TOPGEN]) == tg, bar);
            __builtin_amdgcn_fence(__ATOMIC_ACQUIRE, "agent");
            xb_add(&bar[XB_XGEN(b.x)], 1u);
            asm volatile("s_waitcnt vmcnt(0)" ::: "memory");
        } else {
            XB_SPIN(xb_ld(&bar[XB_XGEN(b.x)]) == gen, bar);
            __builtin_amdgcn_fence(__ATOMIC_ACQUIRE, "agent");
            asm volatile("s_waitcnt vmcnt(0)" ::: "memory");
        }
    }
    __syncthreads();
}

constexpr int N_PHASES = 16;
__global__ void __launch_bounds__(512) mega_fwd(Params p_in) {
    extern __shared__ __attribute__((aligned(16))) unsigned char lds_raw[];
    LAS unsigned char* lds = (LAS unsigned char*)lds_raw;
    cg::grid_group grid = cg::this_grid();
    const int tid = threadIdx.x, lane = tid & 63, wid = __builtin_amdgcn_readfirstlane(tid >> 6);
    const int G = gridDim.x, bx = blockIdx.x;
    const int gw = bx * 8 + wid, NGW = G * 8;
    const int lo = p_in.ph_lo, hi = p_in.ph_hi;
    if (tid < 2) ((volatile LAS unsigned*)(lds + LDS_BAR_OFF))[tid] = 0u;
    __syncthreads();
    if (lo < 0) grid.sync();
    XcdBarrier bar = xcd_barrier_post((unsigned*)(p_in.ws + WS_BAR), (volatile LAS unsigned*)(lds + LDS_BAR_OFF));
#ifndef REP_MASK
#define REP_MASK 0
#endif
#define PHASE(k) if (IN(k)) for (int rep_ = 0; rep_ < (int)((REP_MASK >> (k)) & 1) + 1; ++rep_)
#define PHASE_BEGIN if (rep_) grid.sync(); Params p = p_in; asm volatile("" : "+s"(p.ws), "+s"(p.out)); unsigned char* ws = p.ws; bf16_t* XN = (bf16_t*)(ws + WS_XN); bf16_t* BIG = (bf16_t*)(ws + WS_BIG); (void)XN; (void)BIG;
#ifndef PH_MASK
#define PH_MASK 0xFFFFFF
#endif
#define IN(k) (((PH_MASK >> (k)) & 1) && lo <= (k) && (k) < hi)
#define SEAM(k) do { if (IN(k) && IN((k) + 1)) xcd_barrier(bar); } while (0)

    PHASE(0) { PHASE_BEGIN
        LAS float* scr = (LAS float*)(lds + wid * 16384);
        constexpr int I_INA = 16 * 112, I_INB = 16 * 80, I_MKV = 16 * 16, I_OUT = 16 * 32, I_UP = 16 * 128, I_DN = 64 * 32;
        constexpr int NITEMS = I_INA + I_INB + 2 * I_MKV + 2 * I_OUT + 2 * I_UP + 2 * I_DN;
        for (int it = gw; it < NITEMS; it += NGW) {
            int r = it;
            if (r < I_INA) { transpose_item(p.w_in_a, 1024, INA_SRC, (bf16_t*)(ws + WS_WINA), 112, true, scr, r, lane); continue; } r -= I_INA;
            if (r < I_INB) { transpose_item(p.w_in_b, 1024, 2560, (bf16_t*)(ws + WS_WINB), 80, false, scr, r, lane, p.n_pre_mix + DM); continue; } r -= I_INB;
            if (r < 2 * I_MKV) { const int l = r / I_MKV; transpose_item(p.w_mem_kv + (size_t)l * 1024 * 512, 1024, 512, (bf16_t*)(ws + WS_WMKV) + (size_t)l * 512 * 1024, 16, false, scr, r % I_MKV, lane); continue; } r -= 2 * I_MKV;
            if (r < 2 * I_OUT) { const int l = r / I_OUT; transpose_item(p.w_out + (size_t)l * 1024 * 1024, 1024, 1024, (bf16_t*)(ws + WS_WOUT) + (size_t)l * 1024 * 1024, 32, false, scr, r % I_OUT, lane); continue; } r -= 2 * I_OUT;
            if (r < 2 * I_UP) { const int l = r / I_UP; transpose_item(p.w_up + (size_t)l * 1024 * 4096, 1024, 4096, (bf16_t*)(ws + WS_WUP) + (size_t)l * 4096 * 1024, 128, false, scr, r % I_UP, lane, p.n_pre_mlp + l * DM); continue; } r -= 2 * I_UP;
            { const int l = r / I_DN; transpose_item(p.w_down + (size_t)l * 4096 * 1024, 4096, 1024, (bf16_t*)(ws + WS_WDN) + (size_t)l * 1024 * 4096, 32, false, scr, r % I_DN, lane); }
        }
        for (int m = gw; m < NTOK; m += NGW) rms_row_to_bf16(p.x + (size_t)m * DM, p.n_pre_mix, XN + (size_t)m * DM, lane);
        for (int m = gw; m < NMEMTOK; m += NGW) rms_row_to_bf16(p.mem + (size_t)m * DM, p.mem_norm, (bf16_t*)(ws + WS_MEMN) + (size_t)m * DM, lane);
    }
    SEAM(0);
    PHASE(1) { PHASE_BEGIN
        run_gemm<0>(lds, XN, (const bf16_t*)(ws + WS_WINA), BIG, NTOK, LDA_P, 1024);
        run_gemm<0>(lds, (const bf16_t*)(ws + WS_MEMN), (const bf16_t*)(ws + WS_WMKV), (bf16_t*)(ws + WS_MEMKV), NMEMTOK, 1024, 1024);
    }
    SEAM(1);
    PHASE(2) { PHASE_BEGIN
        for (int grp = bx; grp < NCHH / 8; grp += G)
            d1_unit(p, grp * 8 + wid, lds + wid * D1_REGION, (LAS float*)(lds + wid * D1_REGION + IMG_BYTES), lane);
    }
    SEAM(2);
    PHASE(3) { PHASE_BEGIN
        if (bx < 192) d2_unit(p, bx, lds, tid);
        else for (int u = bx - 192; u < 1024; u += G - 192) xattn_unit(p, u, 0, BIG, LDA_P, 3072, lds, tid);
    }
    SEAM(3);
    for (int layer = 0; layer < 2; ++layer) {
        const int pb = layer == 0 ? 4 : 11;
        if (layer == 1) {
            PHASE(9) { PHASE_BEGIN run_gemm<0>(lds, (const bf16_t*)(ws + WS_XRES), (const bf16_t*)(ws + WS_WINB), BIG, NTOK, LDB_P, 1024, (const float*)(ws + WS_RSTAT)); }
            SEAM(9);
            PHASE(10) { PHASE_BEGIN
                for (int k = 0; k < 3072 / 256; ++k) { const int u = k * 256 + ((k & 1) ? 255 - bx : bx); const int qb = 7 - u / 384, bhd = u % 384; sb_unit(p, bhd, qb, lds, tid); }
                __syncthreads();
                for (int u = bx; u < 1024; u += G) xattn_unit(p, u, 1, BIG, LDB_P, 2304, lds, tid);
            }
            SEAM(10);
        }
        PHASE(pb) { PHASE_BEGIN run_gemm<0>(lds, XN, (const bf16_t*)(ws + WS_WOUT) + (size_t)layer * 1024 * 1024, BIG, NTOK, 1024, 1024); }
        SEAM(pb);
        PHASE(pb + 1) { PHASE_BEGIN
            bf16_t* XR = (bf16_t*)(ws + WS_XRES);
            float* RS = (float*)(ws + WS_RSTAT);
            if (layer == 0) { for (int m = gw; m < NTOK; m += NGW) resid_row<false, false>(p.x + (size_t)m * DM, BIG + (size_t)m * DM, p.n_post_mix, XR + (size_t)m * DM, RS + m, lane); }
            else { for (int m = gw; m < NTOK; m += NGW) resid_row<true, false>(XR + (size_t)m * DM, BIG + (size_t)m * DM, p.n_post_mix + DM, XR + (size_t)m * DM, RS + m, lane); }
        }
        SEAM(pb + 1);
        PHASE(pb + 2) { PHASE_BEGIN run_gemm<2>(lds, (const bf16_t*)(ws + WS_XRES), (const bf16_t*)(ws + WS_WUP) + (size_t)layer * 4096 * 1024, BIG, NTOK, DFF, 1024, (const float*)(ws + WS_RSTAT)); }
        SEAM(pb + 2);
        PHASE(pb + 3) { PHASE_BEGIN run_gemm<0>(lds, BIG, (const bf16_t*)(ws + WS_WDN) + (size_t)layer * 1024 * 4096, XN, NTOK, 1024, DFF); }
        SEAM(pb + 3);
        PHASE(pb + 4) { PHASE_BEGIN
            bf16_t* XR = (bf16_t*)(ws + WS_XRES);
            float* RS = (float*)(ws + WS_RSTAT);
            if (layer == 0) { for (int m = gw; m < NTOK; m += NGW) resid_row<true, false>(XR + (size_t)m * DM, XN + (size_t)m * DM, p.n_post_mlp, XR + (size_t)m * DM, RS + m, lane); }
            else { for (int m = gw; m < NTOK; m += NGW) resid_row<true, true>(XR + (size_t)m * DM, XN + (size_t)m * DM, p.n_post_mlp + DM, p.out + (size_t)m * DM, nullptr, lane); }
        }
        SEAM(pb + 4);
    }
#undef IN
#undef SEAM
}

extern "C" void kernel_launch(void* const* d_in, const int* in_sizes, int n_in, void* d_out, int out_size, void* d_ws, size_t ws_size, hipStream_t stream) {
    static int grid = 0;
    if (grid == 0) {
        int dev = 0, cus = 0, per_cu = 0;
        hipGetDevice(&dev);
        hipDeviceGetAttribute(&cus, hipDeviceAttributeMultiprocessorCount, dev);
        hipFuncSetAttribute((const void*)mega_fwd, hipFuncAttributeMaxDynamicSharedMemorySize, LDS_BYTES);
        hipOccupancyMaxActiveBlocksPerMultiprocessor(&per_cu, (const void*)mega_fwd, 512, LDS_BYTES);
        (void)hipGetLastError();
        if (per_cu < 1) { fprintf(stderr, "kernel_launch: occupancy query says %d blocks/CU\n", per_cu); per_cu = 1; }
        grid = cus;
        if (ws_size < WS_END) { fprintf(stderr, "kernel_launch: workspace too small: %zu < %zu\n", ws_size, (size_t)WS_END); grid = -1; }
    }
    if (grid < 0) return;
    (void)hipMemsetAsync((unsigned char*)d_ws + WS_BAR, 0, XCD_BAR_WORDS * 4, stream);
    Params p{};
    const float** pp = (const float**)&p;
    for (int i = 0; i < 17; ++i) pp[i] = (const float*)d_in[i];
    p.out = (float*)d_out; p.ws = (unsigned char*)d_ws; p.ph_lo = 0; p.ph_hi = N_PHASES;
    void* args[] = {&p};
    hipError_t e = hipLaunchCooperativeKernel((const void*)mega_fwd, dim3(grid), dim3(512), args, LDS_BYTES, stream);
    if (e != hipSuccess) fprintf(stderr, "cooperative launch failed: %s (grid %d)\n", hipGetErrorString(e), grid);
}
```

```cpp
#include <hip/hip_runtime.h>
#include <hip/hip_cooperative_groups.h>
#include <cstdio>
#include <cstdint>
namespace cg = cooperative_groups;

#define DI __device__ __forceinline__
#define LAS __attribute__((address_space(3)))
typedef unsigned short bf16_t;
typedef short bf16x8 __attribute__((ext_vector_type(8)));
typedef short s16x4 __attribute__((ext_vector_type(4)));
typedef float f32x2 __attribute__((ext_vector_type(2)));
typedef float f32x4 __attribute__((ext_vector_type(4)));
typedef float f32x16 __attribute__((ext_vector_type(16)));
typedef unsigned u32x2 __attribute__((ext_vector_type(2)));
typedef unsigned u32x4 __attribute__((ext_vector_type(4)));
typedef __bf16 bf16x2_t __attribute__((ext_vector_type(2)));

constexpr int DM = 1024, BATCH = 32, SEQ = 2048, NTOK = BATCH * SEQ;
constexpr int NMEM = 256, NMEMTOK = BATCH * NMEM;
constexpr int LDA_P = 3584;
constexpr int LDB_P = 2560;
constexpr int INA_SRC = 3340;
constexpr int DFF = 4096;
constexpr int NCH = 32;
constexpr int NCHH = BATCH * NCH * 6;
constexpr float EPSF = 1e-6f;

constexpr size_t MiB = 1u << 20;
constexpr size_t WS_WINA = 0;
constexpr size_t WS_WINB = 8 * MiB;
constexpr size_t WS_WMKV = 14 * MiB;
constexpr size_t WS_WOUT = 16 * MiB;
constexpr size_t WS_WUP = 20 * MiB;
constexpr size_t WS_WDN = 36 * MiB;
constexpr size_t WS_MEMN = 52 * MiB;
constexpr size_t WS_MEMKV = 68 * MiB;
constexpr size_t WS_XN = 84 * MiB;
constexpr size_t WS_BIG = 212 * MiB;
constexpr size_t WS_QD = 724 * MiB;
constexpr size_t WS_KD = 820 * MiB;
constexpr size_t WS_XRES = WS_QD;
constexpr size_t WS_T = 916 * MiB;
constexpr size_t WS_GC = 1012 * MiB;
constexpr size_t WS_RSTAT = WS_GC;
constexpr size_t WS_BAR = 1014 * MiB;
constexpr size_t WS_END = 1015 * MiB;
constexpr size_t DO_U = 0, DO_W = 96 * MiB, DO_AI = 192 * MiB;

constexpr int LDS_BAR_OFF = 159744;
constexpr int LDS_BYTES = 160000;

DI float bf2f(unsigned short h) { return __uint_as_float(((unsigned)h) << 16); }
DI unsigned pk2(float lo, float hi) { f32x2 v = {lo, hi}; bf16x2_t b = __builtin_convertvector(v, bf16x2_t); return __builtin_bit_cast(unsigned, b); }
DI float wave_sum(float v) {
#pragma unroll
    for (int o = 1; o < 64; o <<= 1) v += __shfl_xor(v, o);
    return v;
}
DI void unpack8(u32x4 v, float* f) {
    f[0] = __uint_as_float(v.x << 16); f[1] = __uint_as_float(v.x & 0xffff0000u);
    f[2] = __uint_as_float(v.y << 16); f[3] = __uint_as_float(v.y & 0xffff0000u);
    f[4] = __uint_as_float(v.z << 16); f[5] = __uint_as_float(v.z & 0xffff0000u);
    f[6] = __uint_as_float(v.w << 16); f[7] = __uint_as_float(v.w & 0xffff0000u);
}
DI u32x4 pack8(const float* f) { u32x4 o; o.x = pk2(f[0], f[1]); o.y = pk2(f[2], f[3]); o.z = pk2(f[4], f[5]); o.w = pk2(f[6], f[7]); return o; }
DI s16x4 tr_read(const LAS unsigned char* p) {
    typedef short v4i16_t __attribute__((ext_vector_type(4)));
    return __builtin_bit_cast(s16x4, __builtin_amdgcn_ds_read_tr16_b64_v4i16((LAS v4i16_t*)p));
}
DI bf16x8 cat4(s16x4 lo, s16x4 hi) { return (bf16x8){lo[0], lo[1], lo[2], lo[3], hi[0], hi[1], hi[2], hi[3]}; }
#define MFMA32(a, b, c) __builtin_amdgcn_mfma_f32_32x32x16_bf16((a), (b), (c), 0, 0, 0)
#define MFMA16(a, b, c) __builtin_amdgcn_mfma_f32_16x16x32_bf16((a), (b), (c), 0, 0, 0)
DI float fast_exp(float x) { return __builtin_amdgcn_exp2f(x * 1.4426950408889634f); }
DI float fast_rcp(float x) { return __builtin_amdgcn_rcpf(x); }

DI float row16_sum(float v) {
    v += __builtin_bit_cast(float, __builtin_amdgcn_update_dpp(0, __builtin_bit_cast(int, v), 0x128, 0xF, 0xF, false));
    v += __builtin_bit_cast(float, __builtin_amdgcn_update_dpp(0, __builtin_bit_cast(int, v), 0x124, 0xF, 0xF, false));
    v += __builtin_bit_cast(float, __builtin_amdgcn_update_dpp(0, __builtin_bit_cast(int, v), 0x122, 0xF, 0xF, false));
    v += __builtin_bit_cast(float, __builtin_amdgcn_update_dpp(0, __builtin_bit_cast(int, v), 0x121, 0xF, 0xF, false));
    return v;
}
DI float wave_sum_fast(float v) {
    v = row16_sum(v);
    const int iv = __builtin_bit_cast(int, v);
    return (__builtin_bit_cast(float, __builtin_amdgcn_readlane(iv, 0)) + __builtin_bit_cast(float, __builtin_amdgcn_readlane(iv, 16))) +
           (__builtin_bit_cast(float, __builtin_amdgcn_readlane(iv, 32)) + __builtin_bit_cast(float, __builtin_amdgcn_readlane(iv, 48)));
}
struct Params {
    const float *x, *mem, *mem_norm, *n_pre_mix, *n_post_mix, *n_pre_mlp, *n_post_mlp, *w_in_a, *conv_w, *a_log, *dt_bias, *onorm, *w_in_b, *w_mem_kv, *w_out, *w_up, *w_down;
    float* out; unsigned char* ws; int ph_lo, ph_hi;
};

namespace pg8 {
constexpr int BM = 256, BK = 64, HALF = 128, HTB = HALF * BK * 2, STAGE_BYTES = 8 * HTB, NXCD = 8, WGM = 8;
DI int lds_byte(int r, int c) { const int st = (r >> 4) * 2 + (c >> 5), rr = r & 15, cc = c & 31, ob = rr * 64 + cc * 2; return st * 1024 + (ob ^ (((ob >> 9) & 1) << 5)); }
DI void stage_rc(int b, int& R, int& C) { const int st = b / 1024, sb = b % 1024, swz = sb ^ (((sb >> 9) & 1) << 5); R = (st >> 1) * 16 + swz / 64; C = (st & 1) * 32 + (swz % 64) / 2; }
DI int perm32(int rho) { const int n = rho >> 4, i = rho & 15; return 8 * (i >> 2) + 4 * n + (i & 3); }
struct Unit { int pm, pn; };
struct Gemm { const bf16_t* A; const bf16_t* Bt; int M, N, K; };
struct StaticOrder {
    int nM, nN, nwg, G, c;
    DI void init(int M, int N, int G_, int c_) { nM = M / BM; nN = N / BM; nwg = nM * nN; G = G_; c = c_; }
    DI bool next(int i, Unit& u) const {
        const long L = (long)i * G + c; if (L >= nwg) return false;
        int wgid = (int)L; { const int q = nwg / NXCD, r = nwg % NXCD, xcd = wgid % NXCD, off = wgid / NXCD; wgid = (xcd < r ? xcd * (q + 1) : r * (q + 1) + (xcd - r) * q) + off; }
        const int nig = WGM * nN, gid = wgid / nig, fm = gid * WGM, gsz = (nM - fm) < WGM ? (nM - fm) : WGM;
        u.pm = fm + ((wgid % nig) % gsz); u.pn = (wgid % nig) / gsz; return true;
    }
};
template <int ACT> struct EpiBf16 {
    static constexpr bool PERM = true;
    bf16_t* O; int ldc; const float* rs;
    DI void operator()(const f32x4 (&acc)[2][2][4][2], const Unit& u, int wr, int wc, int fr, int fq) const {
        const int row0 = u.pm * BM + wr * 64 + fr; const int col0 = u.pn * BM + wc * 32 + 8 * fq;
#pragma unroll
        for (int ai = 0; ai < 2; ++ai)
#pragma unroll
            for (int m = 0; m < 4; ++m) { bf16_t* rowp = O + (size_t)(row0 + ai * HALF + m * 16) * ldc + col0;
                float sc = 1.f; if (rs) { sc = rs[row0 + ai * HALF + m * 16]; if (ACT == 2) sc = sc * sc; }
#pragma unroll
                for (int bj = 0; bj < 2; ++bj) { f32x4 v0 = acc[ai][bj][m][0], v1 = acc[ai][bj][m][1];
                    if (ACT == 2) {
#pragma unroll
                        for (int e = 0; e < 4; ++e) { float a = fmaxf(v0[e], 0.f), b = fmaxf(v1[e], 0.f); v0[e] = a * a; v1[e] = b * b; } }
                    v0 = v0 * sc; v1 = v1 * sc;
                    u32x4 w; w.x = pk2(v0[0], v0[1]); w.y = pk2(v0[2], v0[3]); w.z = pk2(v1[0], v1[1]); w.w = pk2(v1[2], v1[3]);
                    *(u32x4*)(rowp + bj * HALF) = w; } }
    }
};

template <class Epi>
DI void gemm_phase(LAS unsigned char* lds, const Gemm g, const StaticOrder& S, const Epi& E) {
    int tid = threadIdx.x; asm volatile("" : "+v"(tid));
    const int wid = __builtin_amdgcn_readfirstlane(tid >> 6), lane = tid & 63, wr = wid >> 2, wc = wid & 3, fr = lane & 15, fq = lane >> 4;
    const int K = g.K, nt = K / BK;
    unsigned voffA[2], voffB[2];
#pragma unroll
    for (int i = 0; i < 2; ++i) { int R, C; stage_rc(tid * 16 + i * 8192, R, C); const int Rb = Epi::PERM ? ((R & ~31) + perm32(R & 31)) : R;
        voffA[i] = (unsigned)(R * K + C) * 2u; voffB[i] = (unsigned)(Rb * K + C) * 2u; }
    const size_t kstep = (size_t)(BK * 2);
    const size_t hstep = (size_t)HALF * K * 2;
    const size_t tstep = 2 * hstep;
    const unsigned ldsw = (unsigned)wid * 1024u;
    const int aoff = lds_byte(wr * 64 + fr, fq * 8), boff = lds_byte(wc * 32 + fr, fq * 8);
#define PG8_SA(b, h) (((b) * 2 + (h)) * HTB)
#define PG8_SB(b, h) ((4 + (b) * 2 + (h)) * HTB)
#define PG8_STAGE(bufoff, gbase, voff) do { _Pragma("unroll") for (int _i = 0; _i < 2; ++_i) \
        __builtin_amdgcn_global_load_lds((const unsigned*)((const char*)(gbase) + (voff)[_i]), (LAS unsigned*)(lds + (bufoff) + ldsw + _i * 8192), 16, 0, 0); } while (0)
#define PG8_LDA(dst, b, h) do { _Pragma("unroll") for (int m = 0; m < 4; ++m) _Pragma("unroll") for (int k = 0; k < 2; ++k) dst[m][k] = *(const LAS bf16x8*)(lds + PG8_SA(b, h) + aoff + m * 2048 + k * 1024); } while (0)
#define PG8_LDB(dst, b, h) do { _Pragma("unroll") for (int n = 0; n < 2; ++n) _Pragma("unroll") for (int k = 0; k < 2; ++k) dst[n][k] = *(const LAS bf16x8*)(lds + PG8_SB(b, h) + boff + n * 2048 + k * 1024); } while (0)
#define PG8_MMA(ai, bj, At, Bt) do { __builtin_amdgcn_s_setprio(1); _Pragma("unroll") for (int m = 0; m < 4; ++m) _Pragma("unroll") for (int n = 0; n < 2; ++n) _Pragma("unroll") for (int k = 0; k < 2; ++k) \
        acc[ai][bj][m][n] = __builtin_amdgcn_mfma_f32_16x16x32_bf16(Bt[n][k], At[m][k], acc[ai][bj][m][n], 0, 0, 0); __builtin_amdgcn_s_setprio(0); } while (0)
#define PG8_WAIT_V(n) asm volatile("s_waitcnt vmcnt(" #n ")" ::: "memory")
#define PG8_WAIT_L(n) asm volatile("s_waitcnt lgkmcnt(" #n ")" ::: "memory")
#define PG8_BAR __builtin_amdgcn_s_barrier()
#define PG8_SCHED __builtin_amdgcn_sched_barrier(0)
    Unit cur, nxt; int ui = 0;
    if (!S.next(0, cur)) return;
    f32x4 acc[2][2][4][2];
#pragma unroll
    for (int a = 0; a < 2; ++a)
#pragma unroll
        for (int b = 0; b < 2; ++b)
#pragma unroll
            for (int m = 0; m < 4; ++m)
#pragma unroll
                for (int n = 0; n < 2; ++n) acc[a][b][m][n] = (f32x4){0.f, 0.f, 0.f, 0.f};
    bf16x8 At[4][2], B0[2][2], B1[2][2];
    const char* cA = (const char*)g.A + (size_t)cur.pm * tstep; const char* cB = (const char*)g.Bt + (size_t)cur.pn * tstep;
    PG8_STAGE(PG8_SB(0, 0), cB, voffB); PG8_STAGE(PG8_SB(0, 1), cB + hstep, voffB); PG8_STAGE(PG8_SA(0, 0), cA, voffA); PG8_STAGE(PG8_SA(0, 1), cA + hstep, voffA);
    if (wr == 1) PG8_BAR;
    PG8_WAIT_V(2); PG8_BAR;
    PG8_STAGE(PG8_SB(1, 0), cB + kstep, voffB); PG8_STAGE(PG8_SA(1, 0), cA + kstep, voffA); PG8_STAGE(PG8_SB(1, 1), cB + hstep + kstep, voffB);
    PG8_WAIT_V(6); PG8_BAR;
    for (;;) {
        const bool has_next = S.next(ui + 1, nxt);
        const char* nA = has_next ? (const char*)g.A + (size_t)nxt.pm * tstep : cA; const char* nB = has_next ? (const char*)g.Bt + (size_t)nxt.pn * tstep : cB;
        for (int t = 0; t < nt; t += 2) {
            const bool last = (t == nt - 2);
            const char* a1 = cA + (size_t)(t + 1) * kstep;
            const char* a2 = last ? nA : cA + (size_t)(t + 2) * kstep; const char* b2 = last ? nB : cB + (size_t)(t + 2) * kstep;
            const char* a3 = a2 + kstep; const char* b3 = b2 + kstep;
            PG8_LDB(B0, 0, 0); PG8_LDB(B1, 0, 1); PG8_SCHED; PG8_LDA(At, 0, 0); PG8_STAGE(PG8_SA(1, 1), a1 + hstep, voffA);
            PG8_WAIT_V(8); PG8_WAIT_L(0); PG8_BAR; PG8_MMA(0, 0, At, B0); PG8_MMA(0, 1, At, B1); PG8_BAR; PG8_SCHED;
            PG8_LDA(At, 0, 1); PG8_STAGE(PG8_SB(0, 0), b2, voffB); PG8_STAGE(PG8_SB(0, 1), b2 + hstep, voffB); PG8_STAGE(PG8_SA(0, 0), a2, voffA);
            PG8_WAIT_V(8); PG8_WAIT_L(0); PG8_BAR; PG8_MMA(1, 0, At, B0); PG8_MMA(1, 1, At, B1); PG8_BAR; PG8_SCHED;
            PG8_LDB(B0, 1, 0); PG8_LDB(B1, 1, 1); PG8_SCHED; PG8_LDA(At, 1, 0); PG8_STAGE(PG8_SA(0, 1), a2 + hstep, voffA);
            PG8_WAIT_V(8); PG8_WAIT_L(0); PG8_BAR; PG8_MMA(0, 0, At, B0); PG8_MMA(0, 1, At, B1); PG8_BAR; PG8_SCHED;
            PG8_LDA(At, 1, 1); PG8_STAGE(PG8_SB(1, 0), b3, voffB); PG8_STAGE(PG8_SB(1, 1), b3 + hstep, voffB); PG8_STAGE(PG8_SA(1, 0), a3, voffA);
            PG8_WAIT_V(8); PG8_WAIT_L(0); PG8_BAR; PG8_MMA(1, 0, At, B0); PG8_MMA(1, 1, At, B1); PG8_BAR; PG8_SCHED;
        }
        if (wr == 0) PG8_BAR;
        E(acc, cur, wr, wc, fr, fq);
        if (!has_next) break;
#pragma unroll
        for (int a = 0; a < 2; ++a)
#pragma unroll
            for (int b = 0; b < 2; ++b)
#pragma unroll
                for (int m = 0; m < 4; ++m)
#pragma unroll
                    for (int n = 0; n < 2; ++n) acc[a][b][m][n] = (f32x4){0.f, 0.f, 0.f, 0.f};
        cur = nxt; cA = nA; cB = nB; ++ui;
        if (wr == 1) PG8_BAR;
    }
    PG8_WAIT_V(0);
    PG8_BAR;
#undef PG8_SA
#undef PG8_SB
#undef PG8_STAGE
#undef PG8_LDA
#undef PG8_LDB
#undef PG8_MMA
#undef PG8_WAIT_V
#undef PG8_WAIT_L
#undef PG8_BAR
#undef PG8_SCHED
}
}

template <int ACT>
DI void run_gemm(LAS unsigned char* lds, const bf16_t* A, const bf16_t* Bt, bf16_t* O, int M, int N, int K, const float* rs = nullptr) {
    pg8::Gemm g{A, Bt, M, N, K}; pg8::StaticOrder S; S.init(M, N, (int)gridDim.x, (int)blockIdx.x);
    pg8::EpiBf16<ACT> E{O, N, rs};
    pg8::gemm_phase<pg8::EpiBf16<ACT>>(lds, g, S, E);
}

DI int ina_srccol(int n) { return n < 3072 ? n : (n < 3328 ? n + 12 : (n < 3340 ? n - 256 : -1)); }
DI void transpose_item(const float* W, int K, int Nsrc, bf16_t* WT, int nblk, bool remap, LAS float* scr, int item, int lane, const float* gk = nullptr) {
    asm volatile("" : "+v"(lane));
    const int kb = item / nblk, nb = item % nblk, k0 = 64 * kb, n0 = 32 * nb;
    const int nn = n0 + (lane & 31); const int col = remap ? ina_srccol(nn) : nn;
    float wv[32];
#pragma unroll
    for (int i = 0; i < 32; ++i) { const int kk = 2 * i + (lane >> 5); wv[i] = col >= 0 ? W[(size_t)(k0 + kk) * Nsrc + col] : 0.f; }
    if (gk) {
#pragma unroll
        for (int i = 0; i < 32; ++i) wv[i] *= gk[k0 + 2 * i + (lane >> 5)]; }
#pragma unroll
    for (int i = 0; i < 32; ++i) { const int kk = 2 * i + (lane >> 5); scr[kk * 33 + (lane & 31)] = wv[i]; }
    asm volatile("s_waitcnt lgkmcnt(0)" ::: "memory");
    const int c = lane & 7;
#pragma unroll
    for (int j = 0; j < 4; ++j) { const int n = (lane >> 3) + 8 * j; const LAS float* s = scr + (8 * c) * 33 + n;
        u32x4 o; o.x = pk2(s[0 * 33], s[1 * 33]); o.y = pk2(s[2 * 33], s[3 * 33]); o.z = pk2(s[4 * 33], s[5 * 33]); o.w = pk2(s[6 * 33], s[7 * 33]);
        *(u32x4*)(WT + (size_t)(n0 + n) * K + k0 + 8 * c) = o; }
    asm volatile("s_waitcnt lgkmcnt(0)" ::: "memory");
}
DI void rms_row_to_bf16(const float* xrow, const float* g, bf16_t* orow, int lane) {
    asm volatile("" : "+v"(lane));
    const f32x4* xr = (const f32x4*)xrow + lane; const f32x4* gr = (const f32x4*)g + lane;
    f32x4 v[4]; float s = 0.f;
#pragma unroll
    for (int j = 0; j < 4; ++j) { v[j] = xr[64 * j]; s += (v[j].x * v[j].x + v[j].y * v[j].y) + (v[j].z * v[j].z + v[j].w * v[j].w); }
    const float rstd = rsqrtf(wave_sum_fast(s) * (1.f / DM) + EPSF);
    u32x2* o8 = (u32x2*)orow + lane;
#pragma unroll
    for (int j = 0; j < 4; ++j) { const f32x4 gg = gr[64 * j]; u32x2 o; o.x = pk2(v[j].x * rstd * gg.x, v[j].y * rstd * gg.y); o.y = pk2(v[j].z * rstd * gg.z, v[j].w * rstd * gg.w); o8[64 * j] = o; }
}
template <bool BASE_BF16, bool OUT_F32, int R>
DI void resid_rows(const void* basep, const bf16_t* yrow, const float* g1, void* outp, float* stat, size_t rstride, int lane) {
    asm volatile("" : "+v"(lane));
    f32x4 y[R][4], b[R][4];
#pragma unroll
    for (int q = 0; q < R; ++q) {
        const u32x2* yr = (const u32x2*)(yrow + q * rstride * DM) + lane;
#pragma unroll
        for (int j = 0; j < 4; ++j) { const u32x2 w = yr[64 * j]; y[q][j].x = __uint_as_float(w.x << 16); y[q][j].y = __uint_as_float(w.x & 0xffff0000u); y[q][j].z = __uint_as_float(w.y << 16); y[q][j].w = __uint_as_float(w.y & 0xffff0000u); }
#pragma unroll
        for (int j = 0; j < 4; ++j) {
            if (BASE_BF16) { const u32x2 w = ((const u32x2*)((const bf16_t*)basep + q * rstride * DM) + lane)[64 * j]; b[q][j].x = __uint_as_float(w.x << 16); b[q][j].y = __uint_as_float(w.x & 0xffff0000u); b[q][j].z = __uint_as_float(w.y << 16); b[q][j].w = __uint_as_float(w.y & 0xffff0000u); }
            else b[q][j] = ((const f32x4*)((const float*)basep + q * rstride * DM) + lane)[64 * j]; }
    }
    const f32x4* g1r = (const f32x4*)g1 + lane;
#pragma unroll
    for (int q = 0; q < R; ++q) {
        float s = 0.f;
#pragma unroll
        for (int j = 0; j < 4; ++j) s += (y[q][j].x * y[q][j].x + y[q][j].y * y[q][j].y) + (y[q][j].z * y[q][j].z + y[q][j].w * y[q][j].w);
        const float rstd = rsqrtf(wave_sum_fast(s) * (1.f / DM) + EPSF);
        float s2 = 0.f;
#pragma unroll
        for (int j = 0; j < 4; ++j) { const f32x4 gg = g1r[64 * j]; y[q][j] = b[q][j] + y[q][j] * rstd * gg; s2 += (y[q][j].x * y[q][j].x + y[q][j].y * y[q][j].y) + (y[q][j].z * y[q][j].z + y[q][j].w * y[q][j].w); }
#pragma unroll
        for (int j = 0; j < 4; ++j) {
            if (OUT_F32) ((f32x4*)((float*)outp + q * rstride * DM) + lane)[64 * j] = y[q][j];
            else { u32x2 o; o.x = pk2(y[q][j].x, y[q][j].y); o.y = pk2(y[q][j].z, y[q][j].w); ((u32x2*)((bf16_t*)outp + q * rstride * DM) + lane)[64 * j] = o; } }
        if (stat) { const float rstd2 = rsqrtf(wave_sum_fast(s2) * (1.f / DM) + EPSF); if (lane == 0) stat[q * rstride] = rstd2; }
    }
}

constexpr int IMG_LD = 136;
constexpr int IMG_BYTES = 64 * IMG_LD * 2;
constexpr int D1_REGION = IMG_BYTES + 1280;
template <int NR>
DI void conv_rows(const bf16_t* projc  , bool first_chunk, const float* cw  , LAS unsigned char* img, int lc, int r0) {
    float w[4][8];
#pragma unroll
    for (int i = 0; i < 4; ++i) { const f32x4 a = *(const f32x4*)(cw + i * 2304), b = *(const f32x4*)(cw + i * 2304 + 4);
        w[i][0] = a.x; w[i][1] = a.y; w[i][2] = a.z; w[i][3] = a.w; w[i][4] = b.x; w[i][5] = b.y; w[i][6] = b.z; w[i][7] = b.w; }
    float xm3[8], xm2[8], xm1[8], cur[8];
    const bool halo = !(first_chunk && r0 == 0);
    if (halo) { unpack8(*(const u32x4*)(projc + (long)(r0 - 3) * LDA_P), xm3); unpack8(*(const u32x4*)(projc + (long)(r0 - 2) * LDA_P), xm2); unpack8(*(const u32x4*)(projc + (long)(r0 - 1) * LDA_P), xm1); }
    else {
#pragma unroll
        for (int j = 0; j < 8; ++j) { xm3[j] = 0.f; xm2[j] = 0.f; xm1[j] = 0.f; } }
#pragma unroll
    for (int rr = 0; rr < NR; ++rr) {
        unpack8(*(const u32x4*)(projc + (long)(r0 + rr) * LDA_P), cur);
        float y[8];
#pragma unroll
        for (int j = 0; j < 8; ++j) { const float v = w[0][j] * xm3[j] + w[1][j] * xm2[j] + w[2][j] * xm1[j] + w[3][j] * cur[j]; y[j] = v * fast_rcp(1.f + fast_exp(-v)); xm3[j] = xm2[j]; xm2[j] = xm1[j]; xm1[j] = cur[j]; }
        *(LAS u32x4*)(img + (r0 + rr) * (IMG_LD * 2) + lc * 2) = pack8(y);
    }
}
DI float row_sumsq(const LAS unsigned char* img, int row) {
    float ss = 0.f;
#pragma unroll
    for (int c = 0; c < 16; ++c) { float f[8]; unpack8(*(const LAS u32x4*)(img + row * (IMG_LD * 2) + c * 16), f);
#pragma unroll
        for (int j = 0; j < 8; ++j) ss += f[j] * f[j]; }
    return ss;
}
DI int crow(int reg, int h) { return (reg & 3) + 8 * (reg >> 2) + 4 * h; }

DI void d1_unit(const Params& p, int ch, LAS unsigned char* wl, LAS float* tb, int lane) {
    asm volatile("" : "+v"(lane));
    const int h = ch % 6, bn = ch / 6, n = bn % NCH, b = bn / NCH;
    const long t0 = (long)b * SEQ + 64 * n;
    const bf16_t* proj = (const bf16_t*)(p.ws + WS_BIG);
    const int r = lane & 31, hh = lane >> 5;
    { const int cc = lane & 15, rg = lane >> 4; const int gcol = 768 + h * 128 + 8 * cc;
      conv_rows<16>(proj + t0 * LDA_P + gcol, n == 0, p.conv_w + gcol, wl, 8 * cc, 16 * rg); }
    asm volatile("s_waitcnt lgkmcnt(0)" ::: "memory");
    const float rk = rsqrtf(row_sumsq(wl, lane) + EPSF);
    const float bl = bf2f(proj[(t0 + lane) * LDA_P + 3328 + h]), al = bf2f(proj[(t0 + lane) * LDA_P + 3334 + h]);
    const float beta = 1.f / (1.f + __expf(-bl));
    const float xa = al + p.dt_bias[h];
    const float sp = xa > 20.f ? xa : log1pf(__expf(xa));
    float gc = -__expf(p.a_log[h]) * sp;
#pragma unroll
    for (int o = 1; o < 64; o <<= 1) { const float t = __shfl_up(gc, o); if (lane >= o) gc += t; }
    f32x16 t00, t01, t11;
#pragma unroll
    for (int i = 0; i < 16; ++i) { t00[i] = 0.f; t01[i] = 0.f; t11[i] = 0.f; }
#pragma unroll
    for (int s = 0; s < 8; ++s) {
        const bf16x8 f0 = *(const LAS bf16x8*)(wl + r * (IMG_LD * 2) + (16 * s + 8 * hh) * 2);
        const bf16x8 f1 = *(const LAS bf16x8*)(wl + (32 + r) * (IMG_LD * 2) + (16 * s + 8 * hh) * 2);
        t00 = MFMA32(f0, f0, t00); t01 = MFMA32(f0, f1, t01); t11 = MFMA32(f1, f1, t11);
    }
    bf16_t* KDc = (bf16_t*)(p.ws + WS_KD) + (size_t)ch * 8192;
    bf16_t* KRc = (bf16_t*)(p.ws + WS_T) + (size_t)ch * 8192;
#pragma unroll
    for (int k = 0; k < 16; ++k) { const int idx = lane + 64 * k, row = idx >> 4, c16 = idx & 15; *(u32x4*)(KRc + row * 128 + 8 * c16) = *(const LAS u32x4*)(wl + row * (IMG_LD * 2) + c16 * 16); }
    const float brk = beta * rk;
    const float sw = brk * __expf(gc);
    tb[lane] = rk; tb[64 + lane] = gc; tb[128 + lane] = beta; tb[192 + lane] = sw;
    LAS float* Lt = (LAS float*)wl;
    asm volatile("s_waitcnt lgkmcnt(0)" ::: "memory");
#pragma unroll
    for (int g = 0; g < 4; ++g) {
        f32x4 rk0 = *(const LAS f32x4*)(tb + 8 * g), rk1 = *(const LAS f32x4*)(tb + 8 * g + 4), rk2 = *(const LAS f32x4*)(tb + 32 + 8 * g), rk3 = *(const LAS f32x4*)(tb + 32 + 8 * g + 4);
        f32x4 gc0 = *(const LAS f32x4*)(tb + 64 + 8 * g), gc1 = *(const LAS f32x4*)(tb + 64 + 8 * g + 4), gc2 = *(const LAS f32x4*)(tb + 96 + 8 * g), gc3 = *(const LAS f32x4*)(tb + 96 + 8 * g + 4);
#pragma unroll
        for (int e = 0; e < 4; ++e) {
            const int reg = 4 * g + e;
            const float own0 = hh == 0 ? t00[reg] : t01[reg], snd = hh == 0 ? t01[reg] : t00[reg];
            const float ra = __shfl_xor(snd, 32), rb = __shfl_xor(t11[reg], 32);
            const int j0 = 8 * g + e, j1 = j0 + 4;
            const float l0 = hh == 0 ? own0 : ra, l1 = hh == 1 ? own0 : ra, l2 = hh == 1 ? rb : 0.f, l3 = hh == 1 ? t11[reg] : 0.f;
            const float v0 = l0 * brk * rk0[e] * __expf(gc - gc0[e]);
            const float v1 = l1 * brk * rk1[e] * __expf(gc - gc1[e]);
            const float v2 = l2 * brk * rk2[e] * __expf(gc - gc2[e]);
            const float v3 = l3 * brk * rk3[e] * __expf(gc - gc3[e]);
            Lt[j0 * 64 + lane] = (j0 < lane) ? v0 : 0.f;
            Lt[j1 * 64 + lane] = (j1 < lane) ? v1 : 0.f;
            Lt[(32 + j0) * 64 + lane] = (32 + j0 < lane) ? v2 : 0.f;
            Lt[(32 + j1) * 64 + lane] = (32 + j1 < lane) ? v3 : 0.f;
        }
    }
    asm volatile("s_waitcnt lgkmcnt(0)" ::: "memory");
    float X[64];
#pragma unroll
    for (int i = 0; i < 64; ++i) X[i] = 0.f;
#pragma unroll
    for (int i = 63; i >= 0; --i) {
        const LAS float* rp = Lt + i * 64;
        if (i < 63) asm volatile("" : "+v"(rp) : "v"(X[i + 1]));
        float acc = -rp[lane];
#pragma unroll
        for (int j4 = ((i + 1) & ~3); j4 < 64; j4 += 4) {
            if (j4 == 32 && i < 28) asm volatile("" : "+v"(rp) : "v"(acc));
            const f32x4 u = *(const LAS f32x4*)(rp + j4);
            acc -= u.x * X[j4]; acc -= u.y * X[j4 + 1]; acc -= u.z * X[j4 + 2]; acc -= u.w * X[j4 + 3]; }
        X[i] = acc;
    }
    u32x4 mineU[4], recvU[4], mineW[4], recvW[4];
#pragma unroll
    for (int s = 0; s < 4; ++s) { u32x4 pu[2], pw[2];
#pragma unroll
        for (int hf = 0; hf < 2; ++hf) { const int c8 = 2 * s + hf; float fu[8], fw[8];
            const f32x4 b0 = *(const LAS f32x4*)(tb + 128 + 8 * c8), b1 = *(const LAS f32x4*)(tb + 128 + 8 * c8 + 4), s0 = *(const LAS f32x4*)(tb + 192 + 8 * c8), s1 = *(const LAS f32x4*)(tb + 192 + 8 * c8 + 4);
#pragma unroll
            for (int j = 0; j < 4; ++j) { const float x0 = X[8 * c8 + j] + ((lane == 8 * c8 + j) ? 1.f : 0.f), x1 = X[8 * c8 + 4 + j] + ((lane == 8 * c8 + 4 + j) ? 1.f : 0.f);
                fu[j] = x0 * b0[j]; fu[4 + j] = x1 * b1[j]; fw[j] = x0 * s0[j]; fw[4 + j] = x1 * s1[j]; }
            pu[hf] = pack8(fu); pw[hf] = pack8(fw); }
        asm volatile("" ::: "memory");
#pragma unroll
        for (int e = 0; e < 4; ++e) { mineU[s][e] = hh ? pu[1][e] : pu[0][e]; mineW[s][e] = hh ? pw[1][e] : pw[0][e];
            const unsigned su = hh ? pu[0][e] : pu[1][e], sw_ = hh ? pw[0][e] : pw[1][e];
            recvU[s][e] = (unsigned)__shfl_xor((int)su, 32); recvW[s][e] = (unsigned)__shfl_xor((int)sw_, 32); }
    }
    ((float*)(p.ws + WS_GC))[(size_t)ch * 64 + lane] = gc;
    asm volatile("s_waitcnt vmcnt(0) lgkmcnt(0)" ::: "memory");
    asm volatile("" : "+v"(lane));
    const int r2 = lane & 31, hh2 = lane >> 5;
#define r r2
#define hh hh2
    {
        const float gl = tb[64 + 63];
#pragma unroll 4
        for (int k = 0; k < 16; ++k) { const int idx = lane + 64 * k, row = idx >> 4, c16 = idx & 15;
            const u32x4 v = *(const u32x4*)(KRc + row * 128 + 8 * c16);
            *(LAS u32x4*)(wl + row * (IMG_LD * 2) + c16 * 16) = v;
            float f[8]; unpack8(v, f); const float sc = tb[row] * __expf(gl - tb[64 + row]);
#pragma unroll
            for (int j = 0; j < 8; ++j) f[j] *= sc;
            *(u32x4*)(KDc + row * 128 + 8 * c16) = pack8(f); }
    }
    const int trrow = (lane & 15) >> 2, trcb = 16 * ((lane >> 4) & 1) + 4 * (lane & 3);
#define D1_PASS(MINE, RECV, DSTOFF) do { \
        asm volatile("s_waitcnt lgkmcnt(0)" ::: "memory"); \
        bf16_t* dstb = (bf16_t*)((unsigned char*)p.out + (DSTOFF)) + (size_t)ch * 8192; \
        _Pragma("unroll 1") for (int mt = 0; mt < 2; ++mt) { \
            bf16x8 bt[4]; \
            _Pragma("unroll") for (int s = 0; s < 4; ++s) { u32x4 t; _Pragma("unroll") for (int e = 0; e < 4; ++e) t[e] = (mt == hh) ? MINE[s][e] : RECV[s][e]; bt[s] = __builtin_bit_cast(bf16x8, t); } \
            _Pragma("unroll") for (int nt = 0; nt < 4; ++nt) { \
                f32x16 a; \
                _Pragma("unroll") for (int i = 0; i < 16; ++i) a[i] = 0.f; \
                _Pragma("unroll") for (int s = 0; s < 4; ++s) { const int row0 = 16 * s + 8 * hh + trrow, cb = 32 * nt + trcb; \
                    const bf16x8 av = cat4(tr_read(wl + row0 * (IMG_LD * 2) + cb * 2), tr_read(wl + (row0 + 4) * (IMG_LD * 2) + cb * 2)); \
                    a = MFMA32(av, bt[s], a); } \
                bf16_t* d = dstb + (32 * mt + r) * 128 + 32 * nt + 4 * hh; \
                _Pragma("unroll") for (int g = 0; g < 4; ++g) { u32x2 o; o.x = pk2(a[4 * g], a[4 * g + 1]); o.y = pk2(a[4 * g + 2], a[4 * g + 3]); *(u32x2*)(d + 8 * g) = o; } \
            } \
        } } while (0)
    D1_PASS(mineW, recvW, DO_W);
    { const int cc = lane & 15, rg = lane >> 4; const int gcol = 1536 + h * 128 + 8 * cc;
      conv_rows<16>(proj + t0 * LDA_P + gcol, n == 0, p.conv_w + gcol, wl, 8 * cc, 16 * rg); }
    D1_PASS(mineU, recvU, DO_U);
#undef D1_PASS
    { const int cc = lane & 15, rg = lane >> 4; const int gcol = h * 128 + 8 * cc;
      conv_rows<16>(proj + t0 * LDA_P + gcol, n == 0, p.conv_w + gcol, wl, 8 * cc, 16 * rg); }
    asm volatile("s_waitcnt lgkmcnt(0)" ::: "memory");
    const float rqv = rsqrtf(row_sumsq(wl, lane) + EPSF) * 0.08838834764831845f;
    tb[256 + lane] = rqv;
    asm volatile("s_waitcnt lgkmcnt(0)" ::: "memory");
    {
        bf16_t* QDc = (bf16_t*)(p.ws + WS_QD) + (size_t)ch * 8192;
#pragma unroll 4
        for (int k = 0; k < 16; ++k) { const int idx = lane + 64 * k, row = idx >> 4, c16 = idx & 15;
            float f[8]; unpack8(*(const LAS u32x4*)(wl + row * (IMG_LD * 2) + c16 * 16), f);
            const float sc = tb[256 + row] * __expf(tb[64 + row]);
#pragma unroll
            for (int j = 0; j < 8; ++j) f[j] *= sc;
            *(u32x4*)(QDc + row * 128 + 8 * c16) = pack8(f); }
    }
    {
        f32x16 a00, a10, a11;
#pragma unroll
        for (int i = 0; i < 16; ++i) { a00[i] = 0.f; a10[i] = 0.f; a11[i] = 0.f; }
#pragma unroll
        for (int s = 0; s < 8; ++s) {
            const bf16x8 fq0 = *(const LAS bf16x8*)(wl + r * (IMG_LD * 2) + (16 * s + 8 * hh) * 2);
            const bf16x8 fq1 = *(const LAS bf16x8*)(wl + (32 + r) * (IMG_LD * 2) + (16 * s + 8 * hh) * 2);
            const bf16x8 fk0 = *(const bf16x8*)(KRc + r * 128 + 16 * s + 8 * hh);
            const bf16x8 fk1 = *(const bf16x8*)(KRc + (32 + r) * 128 + 16 * s + 8 * hh);
            a00 = MFMA32(fk0, fq0, a00); a10 = MFMA32(fk0, fq1, a10); a11 = MFMA32(fk1, fq1, a11);
        }
        bf16_t* AIc = (bf16_t*)((unsigned char*)p.out + DO_AI) + (size_t)ch * 4096;
#pragma unroll
        for (int it = 0; it < 2; ++it) {
            const int i = 32 * it + r; const float rqi = tb[256 + i], gci = tb[64 + i];
#pragma unroll
            for (int jt = 0; jt < 2; ++jt)
#pragma unroll
                for (int g = 0; g < 4; ++g) { float o[4];
                    const f32x4 rkj = *(const LAS f32x4*)(tb + 32 * jt + 8 * g + 4 * hh), gcj = *(const LAS f32x4*)(tb + 64 + 32 * jt + 8 * g + 4 * hh);
#pragma unroll
                    for (int e = 0; e < 4; ++e) { const int j = 32 * jt + 8 * g + 4 * hh + e;
                        const float av = (it == 0) ? (jt == 0 ? a00[4 * g + e] : 0.f) : (jt == 0 ? a10[4 * g + e] : a11[4 * g + e]);
                        const float v = av * rqi * rkj[e] * __expf(gci - gcj[e]); o[e] = (j <= i) ? v : 0.f; }
                    u32x2 w; w.x = pk2(o[0], o[1]); w.y = pk2(o[2], o[3]); *(u32x2*)(AIc + i * 64 + 32 * jt + 8 * g + 4 * hh) = w; }
        }
    }
    asm volatile("s_waitcnt lgkmcnt(0)" ::: "memory");
#undef r
#undef hh
}

constexpr int D2_AIMG_LD = 72;
constexpr int D2_UOFF = 3 * IMG_BYTES, D2_AOFF = D2_UOFF + 64 * 128 * 2;
constexpr int D2_BUF = D2_AOFF + 64 * D2_AIMG_LD * 2;
DI void d2_unit(const Params& p, int bh, LAS unsigned char* lds, int tid) {
    asm volatile("" : "+v"(tid));
    const int b = bh / 6, h = bh % 6;
    const int lane = tid & 63, wid = __builtin_amdgcn_readfirstlane(tid >> 6), col = lane & 15, quad = lane >> 4, e0 = 16 * wid;
    const bf16_t* proj = (const bf16_t*)(p.ws + WS_BIG);
    bf16_t* mix = (bf16_t*)(p.ws + WS_XN);
    const bf16_t* Ug = (const bf16_t*)((unsigned char*)p.out + DO_U); const bf16_t* Wg = (const bf16_t*)((unsigned char*)p.out + DO_W); const bf16_t* Ag = (const bf16_t*)((unsigned char*)p.out + DO_AI);
    const bf16_t* QDg = (const bf16_t*)(p.ws + WS_QD); const bf16_t* KDg = (const bf16_t*)(p.ws + WS_KD);
    const float* gcb = (const float*)(p.ws + WS_GC);
    LAS float* ssx = (LAS float*)(lds + 2 * D2_BUF);
    const float og = p.onorm[e0 + col];
    f32x4 S[8];
#pragma unroll
    for (int i = 0; i < 8; ++i) S[i] = (f32x4){0.f, 0.f, 0.f, 0.f};
    u32x4 pre[9];
#define D2_LOAD(chv) do { _Pragma("unroll") for (int k = 0; k < 9; ++k) { const int ci = tid + 512 * k; \
        if (k < 8) { const int arr = k >> 1; const unsigned voff = (unsigned)(ci & 1023) * 16u; const char* sb = (const char*)(arr == 0 ? Wg : (arr == 1 ? QDg : (arr == 2 ? KDg : Ug))) + (size_t)(chv) * 16384; pre[k] = *(const u32x4*)(sb + voff); } \
        else { const unsigned voff = (unsigned)(ci - 4096) * 16u; const char* sb = (const char*)Ag + (size_t)(chv) * 8192; pre[k] = *(const u32x4*)(sb + voff); } } } while (0)
#define D2_STORE(bufp) do { _Pragma("unroll") for (int k = 0; k < 9; ++k) { const int ci = tid + 512 * k; \
        if (k < 6) { const int arr = k >> 1, rem = ci & 1023, row = rem >> 4, c16 = rem & 15; *(LAS u32x4*)((bufp) + arr * IMG_BYTES + row * (IMG_LD * 2) + c16 * 16) = pre[k]; } \
        else if (k < 8) { *(LAS u32x4*)((bufp) + D2_UOFF + (ci - 3072) * 16) = pre[k]; } \
        else { const int rem = ci - 4096, row = rem >> 3, c8 = rem & 7; *(LAS u32x4*)((bufp) + D2_AOFF + row * (D2_AIMG_LD * 2) + c8 * 16) = pre[k]; } } } while (0)
    { const int ch0 = (b * NCH) * 6 + h; D2_LOAD(ch0); D2_STORE(lds); }
    __syncthreads();
    for (int n = 0; n < NCH; ++n) {
        const int ch = (b * NCH + n) * 6 + h; const long t0 = (long)b * SEQ + 64 * n;
        LAS unsigned char* buf = lds + (n & 1) * D2_BUF;
        if (n + 1 < NCH) { const int chn = ch + 6; D2_LOAD(chn); }
        u32x4 gq[2];
#pragma unroll
        for (int k = 0; k < 2; ++k) { const int idx = tid + 512 * k, row = idx >> 4, c16 = idx & 15; const char* sb = (const char*)(proj + t0 * LDA_P + 2304 + h * 128); gq[k] = *(const u32x4*)(sb + (unsigned)(row * (LDA_P * 2) + c16 * 16)); }
        const float dc = __expf(gcb[(size_t)ch * 64 + 63]);
        bf16x8 Sb[4];
#pragma unroll
        for (int ks = 0; ks < 4; ++ks) { u32x4 w; w.x = pk2(S[2 * ks][0], S[2 * ks][1]); w.y = pk2(S[2 * ks][2], S[2 * ks][3]); w.z = pk2(S[2 * ks + 1][0], S[2 * ks + 1][1]); w.w = pk2(S[2 * ks + 1][2], S[2 * ks + 1][3]); Sb[ks] = __builtin_bit_cast(bf16x8, w); }
        f32x4 vn[4], o[4];
#pragma unroll
        for (int mt = 0; mt < 4; ++mt) {
            f32x4 a1 = (f32x4){0.f, 0.f, 0.f, 0.f}, a2 = (f32x4){0.f, 0.f, 0.f, 0.f};
#pragma unroll
            for (int ks = 0; ks < 4; ++ks) {
                const int off = (16 * mt + col) * (IMG_LD * 2) + (32 * ks + 4 * quad) * 2;
                const bf16x8 fw = cat4(*(const LAS s16x4*)(buf + off), *(const LAS s16x4*)(buf + off + 32));
                const bf16x8 fq = cat4(*(const LAS s16x4*)(buf + IMG_BYTES + off), *(const LAS s16x4*)(buf + IMG_BYTES + off + 32));
                a1 = MFMA16(fw, Sb[ks], a1); a2 = MFMA16(fq, Sb[ks], a2);
            }
#pragma unroll
            for (int j = 0; j < 4; ++j) vn[mt][j] = bf2f(*(const LAS bf16_t*)(buf + D2_UOFF + ((16 * mt + 4 * quad + j) * 128 + e0 + col) * 2)) - a1[j];
            o[mt] = a2;
        }
        bf16x8 Vb[2];
#pragma unroll
        for (int ks = 0; ks < 2; ++ks) { u32x4 w; w.x = pk2(vn[2 * ks][0], vn[2 * ks][1]); w.y = pk2(vn[2 * ks][2], vn[2 * ks][3]); w.z = pk2(vn[2 * ks + 1][0], vn[2 * ks + 1][1]); w.w = pk2(vn[2 * ks + 1][2], vn[2 * ks + 1][3]); Vb[ks] = __builtin_bit_cast(bf16x8, w); }
#pragma unroll
        for (int mt = 0; mt < 4; ++mt)
#pragma unroll
            for (int ks = 0; ks < 2; ++ks) {
                const int off = D2_AOFF + (16 * mt + col) * (D2_AIMG_LD * 2) + (32 * ks + 4 * quad) * 2;
                const bf16x8 fa = cat4(*(const LAS s16x4*)(buf + off), *(const LAS s16x4*)(buf + off + 32));
                o[mt] = MFMA16(fa, Vb[ks], o[mt]);
            }
#pragma unroll
        for (int dt = 0; dt < 8; ++dt) {
            S[dt] = S[dt] * dc;
#pragma unroll
            for (int ks = 0; ks < 2; ++ks) {
                const int off = 2 * IMG_BYTES + (32 * ks + 4 * quad + ((lane & 15) >> 2)) * (IMG_LD * 2) + (16 * dt + 4 * (lane & 3)) * 2;
                const bf16x8 fk = cat4(tr_read(buf + off), tr_read(buf + off + 16 * (IMG_LD * 2)));
                S[dt] = MFMA16(fk, Vb[ks], S[dt]);
            }
        }
        LAS float* sx = ssx + (n & 1) * 512;
#pragma unroll
        for (int mt = 0; mt < 4; ++mt)
#pragma unroll
            for (int j = 0; j < 4; ++j) { float s = o[mt][j] * o[mt][j]; s = row16_sum(s);
                if (col == 0) sx[(16 * mt + 4 * quad + j) * 8 + wid] = s; }
        asm volatile("s_waitcnt lgkmcnt(0)\n\ts_barrier" ::: "memory");
#pragma unroll
        for (int mt = 0; mt < 4; ++mt)
#pragma unroll
            for (int j = 0; j < 4; ++j) { const int row = 16 * mt + 4 * quad + j;
                const f32x4 s0 = *(const LAS f32x4*)(sx + row * 8), s1 = *(const LAS f32x4*)(sx + row * 8 + 4);
                const float tot = (s0.x + s0.y) + (s0.z + s0.w) + (s1.x + s1.y) + (s1.z + s1.w);
                const float rstd = rsqrtf(tot * (1.f / 128.f) + EPSF);
                *(LAS bf16_t*)(buf + row * (IMG_LD * 2) + (e0 + col) * 2) = (bf16_t)(pk2(o[mt][j] * rstd * og, 0.f) & 0xffffu); }
        if (n + 1 < NCH) { LAS unsigned char* nb = lds + ((n + 1) & 1) * D2_BUF; D2_STORE(nb); }
        asm volatile("s_waitcnt lgkmcnt(0)\n\ts_barrier" ::: "memory");
#pragma unroll
        for (int k = 0; k < 2; ++k) { const int idx = tid + 512 * k, row = idx >> 4, c16 = idx & 15;
            float fo[8], fg[8]; unpack8(*(const LAS u32x4*)(buf + row * (IMG_LD * 2) + c16 * 16), fo); unpack8(gq[k], fg);
#pragma unroll
            for (int j = 0; j < 8; ++j) fo[j] *= fg[j] * fast_rcp(1.f + fast_exp(-fg[j]));
            char* db = (char*)(mix + t0 * DM + h * 128); *(u32x4*)(db + (unsigned)(row * (DM * 2) + c16 * 16)) = pack8(fo); }
    }
    __syncthreads();
#undef D2_LOAD
#undef D2_STORE
}

constexpr int KV_LD = 72;
DI f32x16 qk_tile(const LAS unsigned char* Kimg, int key0, const bf16x8* qf, int r, int hh) {
    f32x16 x;
#pragma unroll
    for (int i = 0; i < 16; ++i) x[i] = 0.f;
#pragma unroll
    for (int s = 0; s < 4; ++s) { const bf16x8 kf = *(const LAS bf16x8*)(Kimg + (key0 + r) * (KV_LD * 2) + (16 * s + 8 * hh) * 2); x = MFMA32(kf, qf[s], x); }
    return x;
}
DI void pv_tile(const LAS unsigned char* Vimg, int key0, const f32x16& pr, f32x16* O, int lane) {
    const int hh = lane >> 5;
#pragma unroll
    for (int s = 0; s < 2; ++s) {
        u32x4 w; w.x = pk2(pr[8 * s], pr[8 * s + 1]); w.y = pk2(pr[8 * s + 2], pr[8 * s + 3]); w.z = pk2(pr[8 * s + 4], pr[8 * s + 5]); w.w = pk2(pr[8 * s + 6], pr[8 * s + 7]);
        const bf16x8 pb = __builtin_bit_cast(bf16x8, w);
#pragma unroll
        for (int dt = 0; dt < 2; ++dt) {
            const int row0 = key0 + 16 * s + 4 * hh + ((lane & 15) >> 2), cb = 32 * dt + 16 * ((lane >> 4) & 1) + 4 * (lane & 3);
            const bf16x8 va = cat4(tr_read(Vimg + row0 * (KV_LD * 2) + cb * 2), tr_read(Vimg + (row0 + 8) * (KV_LD * 2) + cb * 2));
            O[dt] = MFMA32(va, pb, O[dt]);
        }
    }
}

DI void xattn_unit(const Params& p, int unit, int layer, const bf16_t* proj, int ldp, int qcol, LAS unsigned char* lds, int tid) {
    asm volatile("" : "+v"(tid));
    const int qb = unit & 7, xh = (unit >> 3) & 3, b = unit >> 5;
    const int lane = tid & 63, wid = __builtin_amdgcn_readfirstlane(tid >> 6), r = lane & 31, hh = lane >> 5;
    LAS unsigned char* Kimg = lds; LAS unsigned char* Vimg = lds + 256 * KV_LD * 2;
    const bf16_t* mkv = (const bf16_t*)(p.ws + WS_MEMKV) + (size_t)b * NMEM * 1024 + layer * 512 + xh * 64;
#pragma unroll
    for (int k = 0; k < 4; ++k) { const int ci = tid + 512 * k, key = ci >> 3, c8 = ci & 7;
        *(LAS u32x4*)(Kimg + key * (KV_LD * 2) + c8 * 16) = *(const u32x4*)(mkv + (size_t)key * 1024 + c8 * 8);
        *(LAS u32x4*)(Vimg + key * (KV_LD * 2) + c8 * 16) = *(const u32x4*)(mkv + (size_t)key * 1024 + 256 + c8 * 8); }
    const long tq = (long)b * SEQ + 256 * qb + 32 * wid + r;
    bf16x8 qf[4];
#pragma unroll
    for (int s = 0; s < 4; ++s) qf[s] = *(const bf16x8*)(proj + tq * ldp + qcol + xh * 64 + 16 * s + 8 * hh);
    __syncthreads();
    float m = -3.0e38f;
#pragma unroll 1
    for (int kt = 0; kt < 8; ++kt) { const f32x16 x = qk_tile(Kimg, 32 * kt, qf, r, hh);
#pragma unroll
        for (int i = 0; i < 16; ++i) m = fmaxf(m, x[i]); }
    m = fmaxf(m, __shfl_xor(m, 32));
    const float c2 = 0.125f * 1.4426950408889634f; const float mb = m * c2;
    f32x16 O[2]; float l = 0.f;
#pragma unroll
    for (int i = 0; i < 16; ++i) { O[0][i] = 0.f; O[1][i] = 0.f; }
#pragma unroll 1
    for (int kt = 0; kt < 8; ++kt) { f32x16 x = qk_tile(Kimg, 32 * kt, qf, r, hh);
#pragma unroll
        for (int i = 0; i < 16; ++i) { x[i] = __builtin_amdgcn_exp2f(x[i] * c2 - mb); l += x[i]; }
        pv_tile(Vimg, 32 * kt, x, O, lane); }
    l += __shfl_xor(l, 32);
    const float il = 1.f / l;
    bf16_t* dst = (bf16_t*)(p.ws + WS_XN) + tq * DM + 768 + xh * 64 + 4 * hh;
#pragma unroll
    for (int dt = 0; dt < 2; ++dt)
#pragma unroll
        for (int g = 0; g < 4; ++g) { u32x2 w; w.x = pk2(O[dt][4 * g] * il, O[dt][4 * g + 1] * il); w.y = pk2(O[dt][4 * g + 2] * il, O[dt][4 * g + 3] * il); *(u32x2*)(dst + 32 * dt + 8 * g) = w; }
    __syncthreads();
}

DI void sb_unit(const Params& p, int bhd, int qb, LAS unsigned char* lds, int tid) {
    asm volatile("" : "+v"(tid));
    const int b = bhd / 12, hd = bhd % 12;
    const int lane = tid & 63, wid = __builtin_amdgcn_readfirstlane(tid >> 6), r = lane & 31, hh = lane >> 5;
    const bf16_t* proj = (const bf16_t*)(p.ws + WS_BIG);
    const long tb = (long)b * SEQ;
    const int wblk = wid < 4 ? wid : 11 - wid;
    const int tq = 256 * qb + 32 * wblk + r;
    const int qhi = 256 * qb + 32 * wblk + 32;
    bf16x8 qf[4];
#pragma unroll
    for (int s = 0; s < 4; ++s) { float f[8]; unpack8(*(const u32x4*)(proj + (tb + tq) * LDB_P + hd * 64 + 16 * s + 8 * hh), f);
#pragma unroll
        for (int j = 0; j < 8; ++j) f[j] *= 0.125f * 1.4426950408889634f;
        qf[s] = __builtin_bit_cast(bf16x8, pack8(f)); }
    const int NT = 2 * (qb + 1);
    const int lkey = tid >> 3, lc8 = tid & 7;
    const bf16_t* kbase = proj + tb * LDB_P + 768 + hd * 64 + lc8 * 8; const bf16_t* vbase = kbase + 768;
    constexpr int SBUF = 2 * 128 * KV_LD * 2;
    u32x4 rk0, rk1, rv0, rv1;
#define SB_LOAD(t) do { const size_t o0 = (size_t)(128 * (t) + lkey) * LDB_P, o1 = o0 + (size_t)64 * LDB_P; rk0 = *(const u32x4*)(kbase + o0); rk1 = *(const u32x4*)(kbase + o1); rv0 = *(const u32x4*)(vbase + o0); rv1 = *(const u32x4*)(vbase + o1); } while (0)
#define SB_STORE(bufp) do { *(LAS u32x4*)((bufp) + lkey * (KV_LD * 2) + lc8 * 16) = rk0; *(LAS u32x4*)((bufp) + (64 + lkey) * (KV_LD * 2) + lc8 * 16) = rk1; \
        *(LAS u32x4*)((bufp) + 128 * KV_LD * 2 + lkey * (KV_LD * 2) + lc8 * 16) = rv0; *(LAS u32x4*)((bufp) + 128 * KV_LD * 2 + (64 + lkey) * (KV_LD * 2) + lc8 * 16) = rv1; } while (0)
#define SB_LOADK(kloc) do { _Pragma("unroll") for (int s = 0; s < 4; ++s) kf[s] = *(const LAS bf16x8*)(Kimg + ((kloc) + r) * (KV_LD * 2) + (16 * s + 8 * hh) * 2); } while (0)
    SB_LOAD(NT - 1);
    f32x16 O[2];
#pragma unroll
    for (int i = 0; i < 16; ++i) { O[0][i] = 0.f; O[1][i] = 0.f; }
    float R = 1.f;
    SB_STORE(lds);
    if (NT >= 2) SB_LOAD(NT - 2);
    asm volatile("s_waitcnt lgkmcnt(0)\n\ts_barrier" ::: "memory");
    int cur = 0;
    const int vrow = 4 * hh + ((lane & 15) >> 2), vcb = 16 * ((lane >> 4) & 1) + 4 * (lane & 3);
#pragma unroll 1
    for (int j = NT - 1; j >= 0; --j) {
        const LAS unsigned char* Kimg = lds + cur * SBUF; const LAS unsigned char* Vimg = Kimg + 128 * KV_LD * 2;
        int sub0 = (qhi - 2 - 128 * j) >> 5; sub0 = sub0 > 3 ? 3 : sub0;
        if (sub0 >= 0) {
            bf16x8 kf[4];
            SB_LOADK(32 * sub0);
#pragma unroll 1
            for (int sub = sub0; sub >= 0; --sub) {
                const int key0 = 128 * j + 32 * sub;
                f32x16 x;
#pragma unroll
                for (int i = 0; i < 16; ++i) x[i] = 0.f;
#pragma unroll
                for (int s = 0; s < 4; ++s) x = MFMA32(kf[s], qf[s], x);
                if (sub > 0) SB_LOADK(32 * (sub - 1));
                s16x4 vf[2][2][2];
#pragma unroll
                for (int s = 0; s < 2; ++s)
#pragma unroll
                    for (int dt = 0; dt < 2; ++dt)
#pragma unroll
                        for (int hf = 0; hf < 2; ++hf) vf[s][dt][hf] = tr_read(Vimg + (32 * sub + 16 * s + 8 * hf + vrow) * (KV_LD * 2) + (32 * dt + vcb) * 2);
                __builtin_amdgcn_sched_barrier(0);
                float cc[16];
#pragma unroll
                for (int i = 0; i < 16; ++i) cc[i] = fast_rcp(1.f + __builtin_amdgcn_exp2f(x[i]));
                if (key0 + 31 >= qhi - 32) {
#pragma unroll
                    for (int i = 0; i < 16; ++i) { const int key = key0 + crow(i, hh); if (key >= tq) cc[i] = 1.f; }
                }
                float G[4], Go[4];
#pragma unroll
                for (int g = 0; g < 4; ++g) { const float p3 = cc[4 * g + 3], p2 = p3 * cc[4 * g + 2], p1 = p2 * cc[4 * g + 1], p0 = p1 * cc[4 * g];
                    x[4 * g + 3] = 1.f - p3; x[4 * g + 2] = p3 - p2; x[4 * g + 1] = p2 - p1; x[4 * g] = p1 - p0; G[g] = p0; }
#pragma unroll
                for (int g = 0; g < 4; ++g) { auto rr = __builtin_amdgcn_permlane32_swap(__float_as_uint(G[g]), __float_as_uint(G[g]), false, false);
                    G[g] = __uint_as_float(rr[0]); Go[g] = __uint_as_float(rr[1]); }
                float suf = R;
#pragma unroll
                for (int g = 3; g >= 0; --g) {
                    const float F = hh == 0 ? suf * Go[g] : suf;
#pragma unroll
                    for (int e = 0; e < 4; ++e) x[4 * g + e] *= F;
                    suf *= G[g] * Go[g];
                }
                R = suf;
#pragma unroll
                for (int s = 0; s < 2; ++s) {
                    u32x4 w; w.x = pk2(x[8 * s], x[8 * s + 1]); w.y = pk2(x[8 * s + 2], x[8 * s + 3]); w.z = pk2(x[8 * s + 4], x[8 * s + 5]); w.w = pk2(x[8 * s + 6], x[8 * s + 7]);
                    const bf16x8 pb = __builtin_bit_cast(bf16x8, w);
#pragma unroll
                    for (int dt = 0; dt < 2; ++dt) O[dt] = MFMA32(cat4(vf[s][dt][0], vf[s][dt][1]), pb, O[dt]);
                }
            }
        }
        if (j >= 1) SB_STORE(lds + (cur ^ 1) * SBUF);
        if (j >= 2) SB_LOAD(j - 2);
        asm volatile("s_waitcnt lgkmcnt(0)\n\ts_barrier" ::: "memory");
        cur ^= 1;
    }
#undef SB_LOAD
#undef SB_STORE
#undef SB_LOADK
    bf16_t* dst = (bf16_t*)(p.ws + WS_XN) + (tb + tq) * DM + hd * 64 + 4 * hh;
#pragma unroll
    for (int dt = 0; dt < 2; ++dt)
#pragma unroll
        for (int g = 0; g < 4; ++g) { u32x2 w; w.x = pk2(O[dt][4 * g], O[dt][4 * g + 1]); w.y = pk2(O[dt][4 * g + 2], O[dt][4 * g + 3]); *(u32x2*)(dst + 32 * dt + 8 * g) = w; }
}

#define XB_TMO      128
#define XB_XCNT(j)  (256  + 64 * (j))
#define XB_XSUB(j)  (1280 + 64 * (j))
#define XB_XGEN(j)  (2304 + 64 * (j))
#define XB_TOP      3328
#define XB_TOPGEN   3392
#define XCD_BAR_WORDS 3456
#define XB_SPIN_CAP (1u << 18)
DI unsigned xb_ld(unsigned* p)              { return __hip_atomic_load(p, __ATOMIC_RELAXED, __HIP_MEMORY_SCOPE_AGENT); }
DI unsigned xb_add(unsigned* p, unsigned v) { return __hip_atomic_fetch_add(p, v, __ATOMIC_RELAXED, __HIP_MEMORY_SCOPE_AGENT); }
DI unsigned xb_xcc_id() { return (unsigned)__builtin_amdgcn_s_getreg((3 << 11) | 20) & 0xFu; }
#define XB_SPIN(cond, bar) do { unsigned _sp = 0; while (cond) { __builtin_amdgcn_s_sleep(1); \
    if ((++_sp & 255u) == 0u) { if (xb_ld(&(bar)[XB_TMO])) break; if (_sp > XB_SPIN_CAP) { atomicAdd(&(bar)[XB_TMO], 1u); break; } } } } while (0)
struct XcdBarrier { unsigned* bar; unsigned x; volatile LAS unsigned* st; };
DI XcdBarrier xcd_barrier_post(unsigned* bar, volatile LAS unsigned* st) {
    XcdBarrier b; b.bar = bar; b.x = xb_xcc_id(); b.st = st;
    if (threadIdx.x == 0) (void)xb_add(&bar[XB_XCNT(b.x)], 1u);
    return b;
}
DI void xcd_barrier_complete(unsigned* bar, unsigned x, unsigned& nloc, unsigned& nx) {
    const unsigned G = gridDim.x * gridDim.y * gridDim.z;
    unsigned sum, cnt, mine, sp = 0u;
    for (;;) {
        sum = 0u; cnt = 0u; mine = 0u;
#pragma unroll
        for (unsigned j = 0; j < 16; ++j) { const unsigned c = xb_ld(&bar[XB_XCNT(j)]); sum += c; cnt += (c > 0u) ? 1u : 0u; mine = (j == x) ? c : mine; }
        if (sum == G) break;
        __builtin_amdgcn_s_sleep(1);
        if ((++sp & 255u) == 0u) { if (xb_ld(&bar[XB_TMO])) break; if (sp > XB_SPIN_CAP) { atomicAdd(&bar[XB_TMO], 1u); break; } }
    }
    nloc = mine > 0u ? mine : 1u; nx = cnt > 0u ? cnt : 1u;
}
DI void xcd_barrier(const XcdBarrier& b) {
    asm volatile("s_waitcnt vmcnt(0)" ::: "memory");
    __syncthreads();
    if (threadIdx.x == 0) {
        unsigned* bar = b.bar;
        __builtin_amdgcn_s_waitcnt(0);
        unsigned nloc = b.st[0], nx = b.st[1];
        if (nloc == 0u) { xcd_barrier_complete(bar, b.x, nloc, nx); b.st[0] = nloc; b.st[1] = nx; }
        const unsigned old = xb_add(&bar[XB_XSUB(b.x)], 1u);
        const unsigned gen = old / nloc;
        if (old + 1u == (gen + 1u) * nloc) {
            __builtin_amdgcn_fence(__ATOMIC_RELEASE, "agent");
            asm volatile("s_waitcnt vmcnt(0)" ::: "memory");
            const unsigned og = xb_add(&bar[XB_TOP], 1u);
            const unsigned tg = og / nx;
            if (og + 1u == (tg + 1u) * nx) xb_add(&bar[XB_TOPGEN], 1u);
            else XB_SPIN(xb_ld(&bar[XB_TOPGEN]) == tg, bar);
            __builtin_amdgcn_fence(__ATOMIC_ACQUIRE, "agent");
            xb_add(&bar[XB_XGEN(b.x)], 1u);
            asm volatile("s_waitcnt vmcnt(0)" ::: "memory");
        } else {
            XB_SPIN(xb_ld(&bar[XB_XGEN(b.x)]) == gen, bar);
            __builtin_amdgcn_fence(__ATOMIC_ACQUIRE, "agent");
            asm volatile("s_waitcnt vmcnt(0)" ::: "memory");
        }
    }
    __syncthreads();
}

constexpr int N_PHASES = 16;
__global__ void __launch_bounds__(512) mega_fwd(Params p_in) {
    extern __shared__ __attribute__((aligned(16))) unsigned char lds_raw[];
    LAS unsigned char* lds = (LAS unsigned char*)lds_raw;
    cg::grid_group grid = cg::this_grid();
    const int tid = threadIdx.x, lane = tid & 63, wid = __builtin_amdgcn_readfirstlane(tid >> 6);
    const int G = gridDim.x, bx = blockIdx.x;
    const int gw = bx * 8 + wid, NGW = G * 8;
    const int lo = p_in.ph_lo, hi = p_in.ph_hi;
    if (tid < 2) ((volatile LAS unsigned*)(lds + LDS_BAR_OFF))[tid] = 0u;
    __syncthreads();
    if (lo < 0) grid.sync();
    XcdBarrier bar = xcd_barrier_post((unsigned*)(p_in.ws + WS_BAR), (volatile LAS unsigned*)(lds + LDS_BAR_OFF));
#ifndef REP_MASK
#define REP_MASK 0
#endif
#define PHASE(k) if (IN(k)) for (int rep_ = 0; rep_ < (int)((REP_MASK >> (k)) & 1) + 1; ++rep_)
#define PHASE_BEGIN if (rep_) grid.sync(); Params p = p_in; asm volatile("" : "+s"(p.ws), "+s"(p.out)); unsigned char* ws = p.ws; bf16_t* XN = (bf16_t*)(ws + WS_XN); bf16_t* BIG = (bf16_t*)(ws + WS_BIG); (void)XN; (void)BIG;
#ifndef PH_MASK
#define PH_MASK 0xFFFFFF
#endif
#define IN(k) (((PH_MASK >> (k)) & 1) && lo <= (k) && (k) < hi)
#define SEAM(k) do { if (IN(k) && IN((k) + 1)) xcd_barrier(bar); } while (0)

    PHASE(0) { PHASE_BEGIN
        LAS float* scr = (LAS float*)(lds + wid * 16384);
        constexpr int I_INA = 16 * 112, I_INB = 16 * 80, I_MKV = 16 * 16, I_OUT = 16 * 32, I_UP = 16 * 128, I_DN = 64 * 32;
        constexpr int NITEMS = I_INA + I_INB + 2 * I_MKV + 2 * I_OUT + 2 * I_UP + 2 * I_DN;
        for (int it = gw; it < NITEMS; it += NGW) {
            int r = it;
            if (r < I_INA) { transpose_item(p.w_in_a, 1024, INA_SRC, (bf16_t*)(ws + WS_WINA), 112, true, scr, r, lane); continue; } r -= I_INA;
            if (r < I_INB) { transpose_item(p.w_in_b, 1024, 2560, (bf16_t*)(ws + WS_WINB), 80, false, scr, r, lane, p.n_pre_mix + DM); continue; } r -= I_INB;
            if (r < 2 * I_MKV) { const int l = r / I_MKV; transpose_item(p.w_mem_kv + (size_t)l * 1024 * 512, 1024, 512, (bf16_t*)(ws + WS_WMKV) + (size_t)l * 512 * 1024, 16, false, scr, r % I_MKV, lane); continue; } r -= 2 * I_MKV;
            if (r < 2 * I_OUT) { const int l = r / I_OUT; transpose_item(p.w_out + (size_t)l * 1024 * 1024, 1024, 1024, (bf16_t*)(ws + WS_WOUT) + (size_t)l * 1024 * 1024, 32, false, scr, r % I_OUT, lane); continue; } r -= 2 * I_OUT;
            if (r < 2 * I_UP) { const int l = r / I_UP; transpose_item(p.w_up + (size_t)l * 1024 * 4096, 1024, 4096, (bf16_t*)(ws + WS_WUP) + (size_t)l * 4096 * 1024, 128, false, scr, r % I_UP, lane, p.n_pre_mlp + l * DM); continue; } r -= 2 * I_UP;
            { const int l = r / I_DN; transpose_item(p.w_down + (size_t)l * 4096 * 1024, 4096, 1024, (bf16_t*)(ws + WS_WDN) + (size_t)l * 1024 * 4096, 32, false, scr, r % I_DN, lane); }
        }
        for (int m = gw; m < NTOK; m += NGW) rms_row_to_bf16(p.x + (size_t)m * DM, p.n_pre_mix, XN + (size_t)m * DM, lane);
        for (int m = gw; m < NMEMTOK; m += NGW) rms_row_to_bf16(p.mem + (size_t)m * DM, p.mem_norm, (bf16_t*)(ws + WS_MEMN) + (size_t)m * DM, lane);
    }
    SEAM(0);
    PHASE(1) { PHASE_BEGIN
        run_gemm<0>(lds, XN, (const bf16_t*)(ws + WS_WINA), BIG, NTOK, LDA_P, 1024);
        run_gemm<0>(lds, (const bf16_t*)(ws + WS_MEMN), (const bf16_t*)(ws + WS_WMKV), (bf16_t*)(ws + WS_MEMKV), NMEMTOK, 1024, 1024);
    }
    SEAM(1);
    PHASE(2) { PHASE_BEGIN
        for (int grp = bx; grp < NCHH / 8; grp += G)
            d1_unit(p, grp * 8 + wid, lds + wid * D1_REGION, (LAS float*)(lds + wid * D1_REGION + IMG_BYTES), lane);
    }
    SEAM(2);
    PHASE(3) { PHASE_BEGIN
        if (bx < 192) d2_unit(p, bx, lds, tid);
        else for (int u = bx - 192; u < 1024; u += G - 192) xattn_unit(p, u, 0, BIG, LDA_P, 3072, lds, tid);
    }
    SEAM(3);
    for (int layer = 0; layer < 2; ++layer) {
        const int pb = layer == 0 ? 4 : 11;
        if (layer == 1) {
            PHASE(9) { PHASE_BEGIN run_gemm<0>(lds, (const bf16_t*)(ws + WS_XRES), (const bf16_t*)(ws + WS_WINB), BIG, NTOK, LDB_P, 1024, (const float*)(ws + WS_RSTAT)); }
            SEAM(9);
            PHASE(10) { PHASE_BEGIN
                for (int k = 0; k < 3072 / 256; ++k) { const int u = k * 256 + ((k & 1) ? 255 - bx : bx); const int qb = 7 - u / 384, bhd = u % 384; sb_unit(p, bhd, qb, lds, tid); }
                __syncthreads();
                for (int u = bx; u < 1024; u += G) xattn_unit(p, u, 1, BIG, LDB_P, 2304, lds, tid);
            }
            SEAM(10);
        }
        PHASE(pb) { PHASE_BEGIN run_gemm<0>(lds, XN, (const bf16_t*)(ws + WS_WOUT) + (size_t)layer * 1024 * 1024, BIG, NTOK, 1024, 1024); }
        SEAM(pb);
        PHASE(pb + 1) { PHASE_BEGIN
            bf16_t* XR = (bf16_t*)(ws + WS_XRES);
            float* RS = (float*)(ws + WS_RSTAT);
            if (layer == 0) { for (int m = gw; m < NTOK; m += 2 * NGW) resid_rows<false, false, 2>(p.x + (size_t)m * DM, BIG + (size_t)m * DM, p.n_post_mix, XR + (size_t)m * DM, RS + m, (size_t)NGW, lane); }
            else { for (int m = gw; m < NTOK; m += 2 * NGW) resid_rows<true, false, 2>(XR + (size_t)m * DM, BIG + (size_t)m * DM, p.n_post_mix + DM, XR + (size_t)m * DM, RS + m, (size_t)NGW, lane); }
        }
        SEAM(pb + 1);
        PHASE(pb + 2) { PHASE_BEGIN run_gemm<2>(lds, (const bf16_t*)(ws + WS_XRES), (const bf16_t*)(ws + WS_WUP) + (size_t)layer * 4096 * 1024, BIG, NTOK, DFF, 1024, (const float*)(ws + WS_RSTAT)); }
        SEAM(pb + 2);
        PHASE(pb + 3) { PHASE_BEGIN run_gemm<0>(lds, BIG, (const bf16_t*)(ws + WS_WDN) + (size_t)layer * 1024 * 4096, XN, NTOK, 1024, DFF); }
        SEAM(pb + 3);
        PHASE(pb + 4) { PHASE_BEGIN
            bf16_t* XR = (bf16_t*)(ws + WS_XRES);
            float* RS = (float*)(ws + WS_RSTAT);
            if (layer == 0) { for (int m = gw; m < NTOK; m += 2 * NGW) resid_rows<true, false, 2>(XR + (size_t)m * DM, XN + (size_t)m * DM, p.n_post_mlp, XR + (size_t)m * DM, RS + m, (size_t)NGW, lane); }
            else { for (int m = gw; m < NTOK; m += 2 * NGW) resid_rows<true, true, 2>(XR + (size_t)m * DM, XN + (size_t)m * DM, p.n_post_mlp + DM, p.out + (size_t)m * DM, nullptr, (size_t)NGW, lane); }
        }
        SEAM(pb + 4);
    }
#undef IN
#undef SEAM
}

extern "C" void kernel_launch(void* const* d_in, const int* in_sizes, int n_in, void* d_out, int out_size, void* d_ws, size_t ws_size, hipStream_t stream) {
    static int grid = 0;
    if (grid == 0) {
        int dev = 0, cus = 0, per_cu = 0;
        hipGetDevice(&dev);
        hipDeviceGetAttribute(&cus, hipDeviceAttributeMultiprocessorCount, dev);
        hipFuncSetAttribute((const void*)mega_fwd, hipFuncAttributeMaxDynamicSharedMemorySize, LDS_BYTES);
        hipOccupancyMaxActiveBlocksPerMultiprocessor(&per_cu, (const void*)mega_fwd, 512, LDS_BYTES);
        (void)hipGetLastError();
        if (per_cu < 1) { fprintf(stderr, "kernel_launch: occupancy query says %d blocks/CU\n", per_cu); per_cu = 1; }
        grid = cus;
        if (ws_size < WS_END) { fprintf(stderr, "kernel_launch: workspace too small: %zu < %zu\n", ws_size, (size_t)WS_END); grid = -1; }
    }
    if (grid < 0) return;
    (void)hipMemsetAsync((unsigned char*)d_ws + WS_BAR, 0, XCD_BAR_WORDS * 4, stream);
    Params p{};
    const float** pp = (const float**)&p;
    for (int i = 0; i < 17; ++i) pp[i] = (const float*)d_in[i];
    p.out = (float*)d_out; p.ws = (unsigned char*)d_ws; p.ph_lo = 0; p.ph_hi = N_PHASES;
    void* args[] = {&p};
    hipError_t e = hipLaunchCooperativeKernel((const void*)mega_fwd, dim3(grid), dim3(512), args, LDS_BYTES, stream);
    if (e != hipSuccess) fprintf(stderr, "cooperative launch failed: %s (grid %d)\n", hipGetErrorString(e), grid);
}
```
